# Optimizing an MI355X kernel written in HIP

```python
import jax, jax.numpy as jnp
from jax import lax
import numpy as np

D_MODEL = 1024
BATCH = 4
SEQ = 8192
DEPTH = 1
DEC_BATCH = 128
DEC_SEQ = 4
PAST_LEN = 16384
PAGE_SIZE = 128

HEAD_DIM = 64
D_MIX = D_MODEL
D_CONV = (3 * D_MIX) // 8
N_MEM_HEADS = 4
D_MEMQ = N_MEM_HEADS * HEAD_DIM
D_SWA = D_MIX - D_CONV - D_MEMQ
N_SWA_HEADS = D_SWA // HEAD_DIM
N_SWA_KV = 2
SWA_GROUP = N_SWA_HEADS // N_SWA_KV
D_SWA_KV = N_SWA_KV * HEAD_DIM
N_MEM = 256
CONV_WIDTH = 3
WINDOW = 128
BLOCK = 128
RMS_EPS = 1e-6
NEG_INF = -1e30
SPLIT_SIZES = (D_CONV, D_CONV, D_CONV, D_CONV, D_SWA, D_SWA_KV, D_SWA_KV, D_SWA, D_MEMQ, D_MEMQ)
D_IN = sum(SPLIT_SIZES)

kernel_name = "hymba_conv_swa_sink_alibi_memxattn_step"


def rms_norm(x, g):
    xf = x.astype(jnp.float32)
    y = xf * lax.rsqrt(jnp.mean(xf * xf, axis=-1, keepdims=True) + RMS_EPS) * g.astype(jnp.float32)
    return y.astype(x.dtype)


def alibi_slopes():
    h = np.arange(1, N_SWA_HEADS + 1, dtype=np.float32)
    return jnp.asarray(np.power(np.float32(2.0), -8.0 * h / N_SWA_HEADS).astype(np.float32))


def project_in(x, pre_g, w_in):
    h = rms_norm(x, pre_g)
    z = h @ w_in
    points = [int(p) for p in np.cumsum(SPLIT_SIZES)[:-1]]
    return jnp.split(z, points, axis=-1)


def project_out(x, y_conv, y_swa, y_mem, post_g, w_out):
    y = jnp.concatenate([y_conv, y_swa, y_mem], axis=-1) @ w_out
    return x + rms_norm(y, post_g)


def short_conv(u_full, conv_w):
    T = u_full.shape[1] - (CONV_WIDTH - 1)
    out = conv_w[0] * u_full[:, 0:T]
    for j in range(1, CONV_WIDTH):
        out = out + conv_w[j] * u_full[:, j:j + T]
    return out


def swa_attention(q, k, v, q_pos, k_pos, sinks):
    N, nb, Tq = q.shape[:3]
    qg = q.reshape(N, nb, Tq, N_SWA_KV, SWA_GROUP, HEAD_DIM).astype(jnp.float32)
    s = jnp.einsum('nbqkgd,nbskd->nbkgqs', qg, k.astype(jnp.float32)) * (HEAD_DIM ** -0.5)
    dist = q_pos[:, :, None] - k_pos[:, None, :]
    valid = (dist >= 0) & (dist < WINDOW) & (k_pos[:, None, :] >= 0)
    slopes = alibi_slopes().reshape(N_SWA_KV, SWA_GROUP)
    s = s - slopes[None, None, :, :, None, None] * jnp.abs(dist).astype(jnp.float32)[None, :, None, None]
    s = jnp.where(valid[None, :, None, None], s, NEG_INF)
    sink = sinks.astype(jnp.float32).reshape(N_SWA_KV, SWA_GROUP)[None, None, :, :, None, None]
    sink = jnp.broadcast_to(sink, s.shape[:-1] + (1,))
    p = jax.nn.softmax(jnp.concatenate([s, sink], axis=-1), axis=-1)[..., :-1]
    o = jnp.einsum('nbkgqs,nbskd->nbqkgd', p, v.astype(jnp.float32))
    return o.reshape(N, nb, Tq, D_SWA).astype(q.dtype)


def mem_attention(q, mk, mv):
    N, T = q.shape[:2]
    qh = q.reshape(N, T, N_MEM_HEADS, HEAD_DIM).astype(jnp.float32)
    s = jnp.einsum('nthd,nmhd->nhtm', qh, mk.astype(jnp.float32)) * (HEAD_DIM ** -0.5)
    p = jax.nn.softmax(s, axis=-1)
    o = jnp.einsum('nhtm,nmhd->nthd', p, mv.astype(jnp.float32))
    return o.reshape(N, T, D_MEMQ).astype(q.dtype)


def mem_kv(mem, mem_g, w_mk, w_mv):
    N, M = mem.shape[:2]
    m = rms_norm(mem, mem_g)
    mk = (m @ w_mk).reshape(N, M, N_MEM_HEADS, HEAD_DIM)
    mv = (m @ w_mv).reshape(N, M, N_MEM_HEADS, HEAD_DIM)
    return mk, mv


def prompt_layer(x, mem, pre_g, post_g, w_in, conv_w, sinks, mem_g, w_mk, w_mv, w_out):
    B, T = x.shape[:2]
    cb, cc, ch, cz, q, k, v, sz, mq, mz = project_in(x, pre_g, w_in)
    u = cc * ch
    u_full = jnp.pad(u, ((0, 0), (CONV_WIDTH - 1, 0), (0, 0)))
    y_conv = cb * short_conv(u_full, conv_w) * jax.nn.silu(cz)
    conv_state = u[:, T - (CONV_WIDTH - 1):]
    nb = T // BLOCK
    k = k.reshape(B, T, N_SWA_KV, HEAD_DIM)
    v = v.reshape(B, T, N_SWA_KV, HEAD_DIM)
    pad = ((0, 0), (BLOCK, 0), (0, 0), (0, 0))
    kb = jnp.pad(k, pad).reshape(B, nb + 1, BLOCK, N_SWA_KV, HEAD_DIM)
    vb = jnp.pad(v, pad).reshape(B, nb + 1, BLOCK, N_SWA_KV, HEAD_DIM)
    k_band = jnp.concatenate([kb[:, :-1], kb[:, 1:]], axis=2)
    v_band = jnp.concatenate([vb[:, :-1], vb[:, 1:]], axis=2)
    qb = q.reshape(B, nb, BLOCK, N_SWA_HEADS, HEAD_DIM)
    q_pos = jnp.arange(T, dtype=jnp.int32).reshape(nb, BLOCK)
    k_pos = (jnp.arange(nb, dtype=jnp.int32)[:, None] * BLOCK - BLOCK
             + jnp.arange(2 * BLOCK, dtype=jnp.int32)[None, :])
    y_swa = swa_attention(qb, k_band, v_band, q_pos, k_pos, sinks).reshape(B, T, D_SWA) * jax.nn.silu(sz)
    keep = min(WINDOW, T)
    swa_k_state = k[:, T - keep:]
    swa_v_state = v[:, T - keep:]
    mk, mv = mem_kv(mem, mem_g, w_mk, w_mv)
    y_mem = mem_attention(mq, mk, mv) * jax.nn.silu(mz)
    y = project_out(x, y_conv, y_swa, y_mem, post_g, w_out)
    return y, conv_state, swa_k_state, swa_v_state, mk, mv


def sample_layer(x, conv_past, swa_k_past, swa_v_past, mk, mv, pre_g, post_g, w_in, conv_w, sinks, w_out):
    N, T = x.shape[:2]
    cb, cc, ch, cz, q, k, v, sz, mq, mz = project_in(x, pre_g, w_in)
    u = cc * ch
    u_full = jnp.concatenate([conv_past.astype(u.dtype), u], axis=1)
    y_conv = cb * short_conv(u_full, conv_w) * jax.nn.silu(cz)
    conv_state = u_full[:, u_full.shape[1] - (CONV_WIDTH - 1):]
    buf = swa_k_past.shape[1]
    k = k.reshape(N, T, N_SWA_KV, HEAD_DIM)
    v = v.reshape(N, T, N_SWA_KV, HEAD_DIM)
    k_all = jnp.concatenate([swa_k_past.astype(k.dtype), k], axis=1)
    v_all = jnp.concatenate([swa_v_past.astype(v.dtype), v], axis=1)
    q_pos = (PAST_LEN + jnp.arange(T, dtype=jnp.int32))[None]
    k_pos = jnp.concatenate([PAST_LEN - buf + jnp.arange(buf, dtype=jnp.int32),
                             PAST_LEN + jnp.arange(T, dtype=jnp.int32)])[None]
    qb = q.reshape(N, 1, T, N_SWA_HEADS, HEAD_DIM)
    y_swa = swa_attention(qb, k_all[:, None], v_all[:, None], q_pos, k_pos, sinks).reshape(N, T, D_SWA)
    y_swa = y_swa * jax.nn.silu(sz)
    swa_k_state = k_all[:, k_all.shape[1] - buf:]
    swa_v_state = v_all[:, v_all.shape[1] - buf:]
    y_mem = mem_attention(mq, mk, mv) * jax.nn.silu(mz)
    y = project_out(x, y_conv, y_swa, y_mem, post_g, w_out)
    return y, conv_state, swa_k_state, swa_v_state


def setup_inputs(seed: int = 0) -> dict:
    key = jax.random.key(seed)
    ks = jax.random.split(key, 20)
    f32 = jnp.float32
    swa_buf = min(WINDOW, PAST_LEN)
    nrm = lambda k, shape, s=1.0: jax.random.normal(k, shape, f32) * s
    return {
        "x_prompt": nrm(ks[0], (BATCH, SEQ, D_MODEL)),
        "x_sample": nrm(ks[1], (DEC_BATCH, DEC_SEQ, D_MODEL)),
        "mem_prompt": nrm(ks[2], (BATCH, N_MEM, D_MODEL)),
        "state_conv": nrm(ks[3], (DEPTH, DEC_BATCH, CONV_WIDTH - 1, D_CONV)),
        "cache_swa_k": nrm(ks[4], (DEPTH, DEC_BATCH, swa_buf, N_SWA_KV, HEAD_DIM)),
        "cache_swa_v": nrm(ks[5], (DEPTH, DEC_BATCH, swa_buf, N_SWA_KV, HEAD_DIM)),
        "cache_mem_k": nrm(ks[6], (DEPTH, DEC_BATCH, N_MEM, N_MEM_HEADS, HEAD_DIM)),
        "cache_mem_v": nrm(ks[7], (DEPTH, DEC_BATCH, N_MEM, N_MEM_HEADS, HEAD_DIM)),
        "pre_norm_g": 1.0 + nrm(ks[8], (DEPTH, D_MODEL), 0.05),
        "post_norm_g": 1.0 + nrm(ks[9], (DEPTH, D_MODEL), 0.05),
        "w_in": nrm(ks[10], (DEPTH, D_MODEL, D_IN), D_MODEL ** -0.5),
        "conv_w": nrm(ks[11], (DEPTH, CONV_WIDTH, D_CONV), CONV_WIDTH ** -0.5),
        "attn_sinks": nrm(ks[12], (DEPTH, N_SWA_HEADS), 0.5),
        "mem_norm_g": 1.0 + nrm(ks[13], (DEPTH, D_MODEL), 0.05),
        "w_mem_k": nrm(ks[14], (DEPTH, D_MODEL, D_MEMQ), D_MODEL ** -0.5),
        "w_mem_v": nrm(ks[15], (DEPTH, D_MODEL, D_MEMQ), D_MODEL ** -0.5),
        "w_out": nrm(ks[16], (DEPTH, D_MIX, D_MODEL), D_MIX ** -0.5),
    }


def reference(x_prompt, x_sample, mem_prompt, state_conv, cache_swa_k, cache_swa_v, cache_mem_k, cache_mem_v,
              pre_norm_g, post_norm_g, w_in, conv_w, attn_sinks, mem_norm_g, w_mem_k, w_mem_v, w_out):
    xp, xs = x_prompt, x_sample
    cp, kp, vp, mkp, mvp, cs, ks_, vs_ = [], [], [], [], [], [], [], []
    for l in range(DEPTH):
        xp, c1, k1, v1, mk1, mv1 = prompt_layer(xp, mem_prompt, pre_norm_g[l], post_norm_g[l], w_in[l], conv_w[l],
                                                attn_sinks[l], mem_norm_g[l], w_mem_k[l], w_mem_v[l], w_out[l])
        xs, c2, k2, v2 = sample_layer(xs, state_conv[l], cache_swa_k[l], cache_swa_v[l], cache_mem_k[l],
                                      cache_mem_v[l], pre_norm_g[l], post_norm_g[l], w_in[l], conv_w[l],
                                      attn_sinks[l], w_out[l])
        cp.append(c1); kp.append(k1); vp.append(v1); mkp.append(mk1); mvp.append(mv1)
        cs.append(c2); ks_.append(k2); vs_.append(v2)
    return (xp, xs, jnp.stack(cp), jnp.stack(kp), jnp.stack(vp), jnp.stack(mkp), jnp.stack(mvp),
            jnp.stack(cs), jnp.stack(ks_), jnp.stack(vs_))
```

```cpp
#include <hip/hip_runtime.h>
#include <cstdio>
#include <cstdint>
namespace pg8 {
#define PG8_LAS __attribute__((address_space(3)))
typedef unsigned short bf16_t;
typedef short bf16x8 __attribute__((ext_vector_type(8)));
typedef float f32x4 __attribute__((ext_vector_type(4)));
typedef unsigned u32x4 __attribute__((ext_vector_type(4)));
constexpr int BM = 256, BK = 64, HALF = 128, HTB = HALF * BK * 2  , STAGE_BYTES = 8 * HTB, NXCD = 8, WGM = 8;

__host__ __device__ __forceinline__ int lds_byte(int r, int c) { const int st = (r >> 4) * 2 + (c >> 5), rr = r & 15, cc = c & 31, ob = rr * 64 + cc * 2; return st * 1024 + (ob ^ (((ob >> 9) & 1) << 5)); }
__host__ __device__ __forceinline__ void stage_rc(int b, int& R, int& C) { const int st = b / 1024, sb = b % 1024, swz = sb ^ (((sb >> 9) & 1) << 5); R = (st >> 1) * 16 + swz / 64; C = (st & 1) * 32 + (swz % 64) / 2; }
__host__ __device__ __forceinline__ int perm32(int rho) { const int n = rho >> 4, i = rho & 15; return 8 * (i >> 2) + 4 * n + (i & 3); }

struct Unit { int pm, pn; };
struct Gemm { const bf16_t* A; const bf16_t* Bt; int M, N, K; };

struct StaticOrder {
    int nM, nN, nwg, G, c;
    __host__ __device__ void init(int M, int N, int G_, int c_) { nM = M / BM; nN = N / BM; nwg = nM * nN; G = G_; c = c_; }
    __host__ __device__ bool next(int i, Unit& u) const {
        const long L = (long)i * G + c; if (L >= nwg) return false;
        int wgid = (int)L; { const int q = nwg / NXCD, r = nwg % NXCD, xcd = wgid % NXCD, off = wgid / NXCD; wgid = (xcd < r ? xcd * (q + 1) : r * (q + 1) + (xcd - r) * q) + off; }
        const int nig = WGM * nN, gid = wgid / nig, fm = gid * WGM, gsz = (nM - fm) < WGM ? (nM - fm) : WGM;
        u.pm = fm + ((wgid % nig) % gsz); u.pn = (wgid % nig) / gsz; return true;
    }
    __device__ __forceinline__ void a_ready(const Unit&) const {}
    __device__ __forceinline__ void done(const Unit&) const {}
};

__device__ __forceinline__ unsigned cvt_pk_bf16(float lo, float hi) { unsigned r; asm volatile("v_cvt_pk_bf16_f32 %0, %1, %2" : "=v"(r) : "v"(lo), "v"(hi)); return r; }
typedef float f32x2 __attribute__((ext_vector_type(2)));
typedef unsigned u32x2 __attribute__((ext_vector_type(2)));
constexpr long OFF_Y = 0, OFF_CP = 34078720, OFF_KP = 34081792, OFF_VP = 34147328, OFF_MKP = 34212864, OFF_MVP = 34475008, OFF_CS = 34737152, OFF_KS = 34835456, OFF_VS = 36932608;
struct EpiPlain {
    static constexpr bool PERM = true, AFTER_DRAIN = false;
    bf16_t* O; int ldc;
    __device__ __forceinline__ void operator()(const f32x4 (&acc)[2][2][4][2], const Unit& u, int wr, int wc, int fr, int fq) const {
        const int rowb = u.pm * BM + wr * 64 + fr; const int cw = wc * 32 + 8 * fq;
#pragma unroll
        for (int ai = 0; ai < 2; ++ai)
#pragma unroll
            for (int m = 0; m < 4; ++m) { bf16_t* rp = O + (size_t)(rowb + ai * HALF + m * 16) * ldc + u.pn * BM + cw;
#pragma unroll
                for (int bj = 0; bj < 2; ++bj) { const f32x4 v0 = acc[ai][bj][m][0], v1 = acc[ai][bj][m][1];
                    u32x4 w; w.x = cvt_pk_bf16(v0[0], v0[1]); w.y = cvt_pk_bf16(v0[2], v0[3]); w.z = cvt_pk_bf16(v1[0], v1[1]); w.w = cvt_pk_bf16(v1[2], v1[3]);
                    *(u32x4*)(rp + bj * HALF) = w; } }
    }
};
struct EpiZ {
    static constexpr bool PERM = true, AFTER_DRAIN = false;
    bf16_t* Z; bf16_t* VT; bf16_t* MK; bf16_t* MVT; float* out;
    __device__ __forceinline__ void operator()(const f32x4 (&acc)[2][2][4][2], const Unit& u, int wr, int wc, int fr, int fq) const {
        const int rowb = u.pm * BM + wr * 64 + fr; const int cw = wc * 32 + 8 * fq;
        if (u.pn < 11) {
#pragma unroll
            for (int ai = 0; ai < 2; ++ai)
#pragma unroll
                for (int m = 0; m < 4; ++m) { bf16_t* rp = Z + (size_t)(rowb + ai * HALF + m * 16) * 3072 + u.pn * BM + cw;
#pragma unroll
                    for (int bj = 0; bj < 2; ++bj) { const f32x4 v0 = acc[ai][bj][m][0], v1 = acc[ai][bj][m][1];
                        u32x4 w; w.x = cvt_pk_bf16(v0[0], v0[1]); w.y = cvt_pk_bf16(v0[2], v0[3]); w.z = cvt_pk_bf16(v1[0], v1[1]); w.w = cvt_pk_bf16(v1[2], v1[3]);
                        *(u32x4*)(rp + bj * HALF) = w; } }
        } else if (u.pn == 11) {
#pragma unroll
            for (int ai = 0; ai < 2; ++ai)
#pragma unroll
                for (int m = 0; m < 4; ++m) {
                    const int row = rowb + ai * HALF + m * 16;
                    long so = -1;
                    const bool prompt = row < 32768;
                    const int t = row & 8191, b = row >> 13;
                    if (prompt) { if (t >= 8064) so = (long)(b * 128 + (t - 8064)) * 128 + cw; }
                    else { const int rs = row - 32768; so = (long)((rs >> 2) * 128 + 124 + (rs & 3)) * 128 + cw; }
                    {
                        const f32x4 v0 = acc[ai][0][m][0], v1 = acc[ai][0][m][1];
                        u32x4 w; w.x = cvt_pk_bf16(v0[0], v0[1]); w.y = cvt_pk_bf16(v0[2], v0[3]); w.z = cvt_pk_bf16(v1[0], v1[1]); w.w = cvt_pk_bf16(v1[2], v1[3]);
                        *(u32x4*)(Z + (size_t)row * 3072 + 2816 + cw) = w;
                        if (so >= 0) { float* sp = out + (prompt ? OFF_KP : OFF_KS) + so; *(f32x4*)sp = v0; *(f32x4*)(sp + 4) = v1; }
                    }
                    {
                        const f32x4 v0 = acc[ai][1][m][0], v1 = acc[ai][1][m][1];
                        if (prompt) {
                            const unsigned w0 = cvt_pk_bf16(v0[0], v0[1]), w1 = cvt_pk_bf16(v0[2], v0[3]), w2 = cvt_pk_bf16(v1[0], v1[1]), w3 = cvt_pk_bf16(v1[2], v1[3]);
                            bf16_t* vp = VT + ((size_t)(b * 128 + cw) * 8192 + t);
                            vp[0 * 8192] = (bf16_t)w0; vp[1 * 8192] = (bf16_t)(w0 >> 16); vp[2 * 8192] = (bf16_t)w1; vp[3 * 8192] = (bf16_t)(w1 >> 16);
                            vp[4 * 8192] = (bf16_t)w2; vp[5 * 8192] = (bf16_t)(w2 >> 16); vp[6 * 8192] = (bf16_t)w3; vp[7 * 8192] = (bf16_t)(w3 >> 16);
                        }
                        if (so >= 0) { float* sp = out + (prompt ? OFF_VP : OFF_VS) + so; *(f32x4*)sp = v0; *(f32x4*)(sp + 4) = v1; }
                    }
                }
        } else {
            const bool isk = (u.pn == 12);
#pragma unroll
            for (int ai = 0; ai < 2; ++ai)
#pragma unroll
                for (int m = 0; m < 4; ++m) {
                    const int mrow = rowb + ai * HALF + m * 16 - 33280;
#pragma unroll
                    for (int bj = 0; bj < 2; ++bj) {
                        const f32x4 v0 = acc[ai][bj][m][0], v1 = acc[ai][bj][m][1]; const int col = cw + bj * HALF;
                        float* sp = out + (isk ? OFF_MKP : OFF_MVP) + (long)mrow * 256 + col; *(f32x4*)sp = v0; *(f32x4*)(sp + 4) = v1;
                        const unsigned w0 = cvt_pk_bf16(v0[0], v0[1]), w1 = cvt_pk_bf16(v0[2], v0[3]), w2 = cvt_pk_bf16(v1[0], v1[1]), w3 = cvt_pk_bf16(v1[2], v1[3]);
                        if (isk) { u32x4 w; w.x = w0; w.y = w1; w.z = w2; w.w = w3; *(u32x4*)(MK + (size_t)mrow * 256 + col) = w; }
                        else { bf16_t* vp = MVT + ((size_t)((mrow >> 8) * 256 + col) * 256 + (mrow & 255));
                            vp[0 * 256] = (bf16_t)w0; vp[1 * 256] = (bf16_t)(w0 >> 16); vp[2 * 256] = (bf16_t)w1; vp[3 * 256] = (bf16_t)(w1 >> 16);
                            vp[4 * 256] = (bf16_t)w2; vp[5 * 256] = (bf16_t)(w2 >> 16); vp[6 * 256] = (bf16_t)w3; vp[7 * 256] = (bf16_t)(w3 >> 16); }
                    }
                }
        }
    }
};
struct OrderP1 {
    StaticOrder so; int G, c;
    __host__ __device__ void init(int G_, int c_) { so.init(32768, 3072, G_, c_); G = G_; c = c_; }
    __host__ __device__ bool next(int i, Unit& u) const {
        if (so.next(i, u)) return true;
        const long e = (long)i * G + c - so.nwg; if (e < 0 || e >= 32) return false;
        if (e < 24) { u.pm = 128 + (int)e / 12; u.pn = (int)e % 12; } else { u.pm = 130 + (int)(e - 24) / 2; u.pn = 12 + (int)(e - 24) % 2; }
        return true;
    }
    __device__ __forceinline__ void a_ready(const Unit&) const {}
    __device__ __forceinline__ void done(const Unit&) const {}
};
template <class Epi, class Sched, bool ALIGN_EPI = false, bool SP2 = false>
__device__ __forceinline__ void gemm_phase(PG8_LAS unsigned char* lds, const Gemm g, const Sched& S, const Epi& E) {
    const int tid = threadIdx.x, wid = __builtin_amdgcn_readfirstlane(tid >> 6), lane = tid & 63, wr = wid >> 2, wc = wid & 3, fr = lane & 15, fq = lane >> 4;
    const int K = g.K, nt = K / BK;
    unsigned voffA[2], voffB[2];
#pragma unroll
    for (int i = 0; i < 2; ++i) { int R, C; stage_rc(tid * 16 + i * 8192, R, C); const int Rb = Epi::PERM ? ((R & ~31) + perm32(R & 31)) : R;
        voffA[i] = (unsigned)(R * K + C) * 2u; voffB[i] = (unsigned)(Rb * K + C) * 2u; }
    const size_t kstep = (size_t)(BK * 2);
    const size_t hstep = (size_t)HALF * K * 2;
    const size_t tstep = 2 * hstep;
    const unsigned ldsw = (unsigned)wid * 1024u;
    const int aoff = lds_byte(wr * 64 + fr, fq * 8), boff = lds_byte(wc * 32 + fr, fq * 8);
#define PG8_SA(b, h) (((b) * 2 + (h)) * HTB)
#define PG8_SB(b, h) ((4 + (b) * 2 + (h)) * HTB)
#define PG8_STAGE(bufoff, gbase, voff) do { _Pragma("unroll") for (int _i = 0; _i < 2; ++_i) \
        __builtin_amdgcn_global_load_lds((const unsigned*)((const char*)(gbase) + (voff)[_i]), (PG8_LAS unsigned*)(lds + (bufoff) + ldsw + _i * 8192), 16, 0, 0); } while (0)
#define PG8_LDA(dst, b, h) do { _Pragma("unroll") for (int m = 0; m < 4; ++m) _Pragma("unroll") for (int k = 0; k < 2; ++k) dst[m][k] = *(const PG8_LAS bf16x8*)(lds + PG8_SA(b, h) + aoff + m * 2048 + k * 1024); } while (0)
#define PG8_LDB(dst, b, h) do { _Pragma("unroll") for (int n = 0; n < 2; ++n) _Pragma("unroll") for (int k = 0; k < 2; ++k) dst[n][k] = *(const PG8_LAS bf16x8*)(lds + PG8_SB(b, h) + boff + n * 2048 + k * 1024); } while (0)
#define PG8_MMA(ai, bj, At, Bt) do { __builtin_amdgcn_s_setprio(1); _Pragma("unroll") for (int m = 0; m < 4; ++m) _Pragma("unroll") for (int n = 0; n < 2; ++n) _Pragma("unroll") for (int k = 0; k < 2; ++k) \
        acc[ai][bj][m][n] = __builtin_amdgcn_mfma_f32_16x16x32_bf16(Bt[n][k], At[m][k], acc[ai][bj][m][n], 0, 0, 0); __builtin_amdgcn_s_setprio(0); } while (0)
#define PG8_WAIT_V(n) asm volatile("s_waitcnt vmcnt(" #n ")" ::: "memory")
#define PG8_WAIT_L(n) asm volatile("s_waitcnt lgkmcnt(" #n ")" ::: "memory")
#define PG8_BAR __builtin_amdgcn_s_barrier()
#define PG8_SCHED __builtin_amdgcn_sched_barrier(0)
    Unit cur, nxt; int ui = 0;
    if (!S.next(0, cur)) return;
    f32x4 acc[2][2][4][2];
#pragma unroll
    for (int a = 0; a < 2; ++a)
#pragma unroll
        for (int b = 0; b < 2; ++b)
#pragma unroll
            for (int m = 0; m < 4; ++m)
#pragma unroll
                for (int n = 0; n < 2; ++n) acc[a][b][m][n] = (f32x4){0.f, 0.f, 0.f, 0.f};
    bf16x8 At[4][2], B0[2][2], B1[2][2];
    const char* cA = (const char*)g.A + (size_t)cur.pm * tstep; const char* cB = (const char*)g.Bt + (size_t)cur.pn * tstep;
    S.a_ready(cur);
    if constexpr (SP2) {
        PG8_STAGE(PG8_SB(0, 0), cB, voffB); PG8_STAGE(PG8_SB(0, 1), cB + hstep, voffB); PG8_STAGE(PG8_SA(0, 0), cA, voffA); PG8_STAGE(PG8_SA(0, 1), cA + hstep, voffA);
        if (wr == 1) PG8_BAR;
        PG8_WAIT_V(2); PG8_BAR;
        PG8_STAGE(PG8_SB(1, 0), cB + kstep, voffB); PG8_STAGE(PG8_SA(1, 0), cA + kstep, voffA); PG8_STAGE(PG8_SB(1, 1), cB + hstep + kstep, voffB);
        PG8_WAIT_V(6); PG8_BAR;
    } else {
        PG8_STAGE(PG8_SB(0, 0), cB, voffB); PG8_STAGE(PG8_SA(0, 0), cA, voffA); PG8_STAGE(PG8_SB(0, 1), cB + hstep, voffB); PG8_STAGE(PG8_SA(0, 1), cA + hstep, voffA);
        if (wr == 1) PG8_BAR;
        PG8_WAIT_V(4); PG8_BAR;
        PG8_STAGE(PG8_SB(1, 0), cB + kstep, voffB); PG8_STAGE(PG8_SA(1, 0), cA + kstep, voffA); PG8_STAGE(PG8_SB(1, 1), cB + hstep + kstep, voffB);
        PG8_WAIT_V(6); PG8_BAR;
    }
    for (;;) {
        const bool has_next = S.next(ui + 1, nxt);
        const char* nA = has_next ? (const char*)g.A + (size_t)nxt.pm * tstep : cA; const char* nB = has_next ? (const char*)g.Bt + (size_t)nxt.pn * tstep : cB;
        for (int t = 0; t < nt; t += 2) {
            const bool last = (t == nt - 2);
            const char* a1 = cA + (size_t)(t + 1) * kstep;
            const char* a2 = last ? nA : cA + (size_t)(t + 2) * kstep; const char* b2 = last ? nB : cB + (size_t)(t + 2) * kstep;
            const char* a3 = a2 + kstep; const char* b3 = b2 + kstep;
            if (last && has_next) S.a_ready(nxt);
            if constexpr (SP2) {
            PG8_LDB(B0, 0, 0); PG8_LDB(B1, 0, 1); PG8_SCHED; PG8_LDA(At, 0, 0); PG8_STAGE(PG8_SA(1, 1), a1 + hstep, voffA);
            PG8_WAIT_V(8); PG8_WAIT_L(0); PG8_BAR; PG8_MMA(0, 0, At, B0); PG8_MMA(0, 1, At, B1); PG8_BAR; PG8_SCHED;
            PG8_LDA(At, 0, 1); PG8_STAGE(PG8_SB(0, 0), b2, voffB); PG8_STAGE(PG8_SB(0, 1), b2 + hstep, voffB); PG8_STAGE(PG8_SA(0, 0), a2, voffA);
            PG8_WAIT_V(8); PG8_WAIT_L(0); PG8_BAR; PG8_MMA(1, 0, At, B0); PG8_MMA(1, 1, At, B1); PG8_BAR; PG8_SCHED;
            PG8_LDB(B0, 1, 0); PG8_LDB(B1, 1, 1); PG8_SCHED; PG8_LDA(At, 1, 0); PG8_STAGE(PG8_SA(0, 1), a2 + hstep, voffA);
            PG8_WAIT_V(8); PG8_WAIT_L(0); PG8_BAR; PG8_MMA(0, 0, At, B0); PG8_MMA(0, 1, At, B1); PG8_BAR; PG8_SCHED;
            PG8_LDA(At, 1, 1); PG8_STAGE(PG8_SB(1, 0), b3, voffB); PG8_STAGE(PG8_SB(1, 1), b3 + hstep, voffB); PG8_STAGE(PG8_SA(1, 0), a3, voffA);
            PG8_WAIT_V(8); PG8_WAIT_L(0); PG8_BAR; PG8_MMA(1, 0, At, B0); PG8_MMA(1, 1, At, B1); PG8_BAR; PG8_SCHED;
            } else {
            PG8_LDB(B0, 0, 0); PG8_SCHED; PG8_LDA(At, 0, 0); PG8_STAGE(PG8_SA(1, 1), a1 + hstep, voffA);
            PG8_WAIT_L(8); PG8_BAR; PG8_WAIT_L(0); PG8_MMA(0, 0, At, B0); PG8_BAR; PG8_SCHED;
            PG8_LDB(B1, 0, 1); PG8_STAGE(PG8_SB(0, 0), b2, voffB);
            PG8_BAR; PG8_WAIT_L(0); PG8_MMA(0, 1, At, B1); PG8_BAR;
            PG8_LDA(At, 0, 1); PG8_STAGE(PG8_SA(0, 0), a2, voffA);
            PG8_BAR; PG8_WAIT_L(0); PG8_MMA(1, 0, At, B0); PG8_BAR; PG8_SCHED;
            PG8_STAGE(PG8_SB(0, 1), b2 + hstep, voffB);
            PG8_WAIT_V(6); PG8_BAR; PG8_MMA(1, 1, At, B1); PG8_BAR;
            PG8_LDB(B0, 1, 0); PG8_SCHED; PG8_LDA(At, 1, 0); PG8_STAGE(PG8_SA(0, 1), a2 + hstep, voffA);
            PG8_WAIT_L(8); PG8_BAR; PG8_WAIT_L(0); PG8_MMA(0, 0, At, B0); PG8_BAR; PG8_SCHED;
            PG8_LDB(B1, 1, 1); PG8_STAGE(PG8_SB(1, 0), b3, voffB);
            PG8_BAR; PG8_WAIT_L(0); PG8_MMA(0, 1, At, B1); PG8_BAR;
            PG8_LDA(At, 1, 1); PG8_STAGE(PG8_SA(1, 0), a3, voffA);
            PG8_BAR; PG8_WAIT_L(0); PG8_MMA(1, 0, At, B0); PG8_BAR; PG8_SCHED;
            PG8_STAGE(PG8_SB(1, 1), b3 + hstep, voffB);
            PG8_WAIT_V(6); PG8_BAR; PG8_MMA(1, 1, At, B1); PG8_BAR;
            }
        }
        if constexpr (ALIGN_EPI) { if (wr == 0) PG8_BAR; }
        if constexpr (!Epi::AFTER_DRAIN) { E(acc, cur, wr, wc, fr, fq); S.done(cur); }
        if (!has_next) break;
#pragma unroll
        for (int a = 0; a < 2; ++a)
#pragma unroll
            for (int b = 0; b < 2; ++b)
#pragma unroll
                for (int m = 0; m < 4; ++m)
#pragma unroll
                    for (int n = 0; n < 2; ++n) acc[a][b][m][n] = (f32x4){0.f, 0.f, 0.f, 0.f};
        cur = nxt; cA = nA; cB = nB; ++ui;
        if constexpr (ALIGN_EPI) { if (wr == 1) PG8_BAR; }
    }
    PG8_WAIT_V(0);
    if constexpr (!ALIGN_EPI) { if (wr == 0) PG8_BAR; }
    PG8_BAR;
    if constexpr (Epi::AFTER_DRAIN) { E.fused(acc, cur, wr, wc, fr, fq, lds, wid, lane); S.done(cur); }
#undef PG8_SA
#undef PG8_SB
#undef PG8_STAGE
#undef PG8_LDA
#undef PG8_LDB
#undef PG8_MMA
#undef PG8_WAIT_V
#undef PG8_WAIT_L
#undef PG8_BAR
#undef PG8_SCHED
}
}
#define GAS __attribute__((address_space(1)))
#define LAS __attribute__((address_space(3)))
typedef unsigned short bf16;
typedef unsigned v4u __attribute__((ext_vector_type(4)));
typedef float f32x4 __attribute__((ext_vector_type(4)));
typedef short bf16x8 __attribute__((ext_vector_type(8)));
typedef GAS unsigned gu32;
typedef GAS unsigned long long gu64;
#define RLX_AGENT __ATOMIC_RELAXED, __HIP_MEMORY_SCOPE_AGENT
#define LDS_WAIT() asm volatile("s_waitcnt lgkmcnt(0)" ::: "memory")
#define VM_WAIT() asm volatile("s_waitcnt vmcnt(0)" ::: "memory")
__device__ __forceinline__ unsigned long long rt() { return __builtin_amdgcn_s_memrealtime(); }
__device__ __forceinline__ unsigned f2bf(float f) { unsigned u = __builtin_bit_cast(unsigned, f); return (u + 0x7fffu + ((u >> 16) & 1u)) >> 16; }
__device__ __forceinline__ unsigned pk2(float lo, float hi) { return f2bf(lo) | (f2bf(hi) << 16); }

#define XB_TMO      128
#define XB_XCNT(j)  (256  + 64 * (j))
#define XB_XSUB(j)  (1280 + 64 * (j))
#define XB_XGEN(j)  (2304 + 64 * (j))
#define XB_TOP      3328
#define XB_TOPGEN   3392
#define XCD_BAR_WORDS 3456
#define XB_SPIN_CAP (1u << 18)

__device__ __forceinline__ unsigned xb_ld(unsigned* p)              { return __hip_atomic_load(p, __ATOMIC_RELAXED, __HIP_MEMORY_SCOPE_AGENT); }
__device__ __forceinline__ unsigned xb_add(unsigned* p, unsigned v) { return __hip_atomic_fetch_add(p, v, __ATOMIC_RELAXED, __HIP_MEMORY_SCOPE_AGENT); }
__device__ __forceinline__ unsigned xb_xcc_id() { return (unsigned)__builtin_amdgcn_s_getreg((3 << 11) | 20) & 0xFu; }
#define XB_SPIN(cond, bar) do { unsigned _sp = 0; while (cond) { __builtin_amdgcn_s_sleep(1); \
    if ((++_sp & 255u) == 0u) { if (xb_ld(&(bar)[XB_TMO])) break; if (_sp > XB_SPIN_CAP) { atomicAdd(&(bar)[XB_TMO], 1u); break; } } } } while (0)

struct XcdBarrier {
    unsigned* bar; unsigned x;
    volatile LAS unsigned* st;
};

__device__ __forceinline__ XcdBarrier xcd_barrier_post(unsigned* bar, volatile LAS unsigned* st) {
    XcdBarrier b; b.bar = bar; b.x = xb_xcc_id(); b.st = st;
    if (threadIdx.x == 0) (void)xb_add(&bar[XB_XCNT(b.x)], 1u);
    return b;
}
__device__ __forceinline__ void xcd_barrier_complete(unsigned* bar, unsigned x, unsigned& nloc, unsigned& nx) {
    const unsigned G = gridDim.x * gridDim.y * gridDim.z;
    unsigned sum, cnt, mine, sp = 0u;
    for (;;) {
        sum = 0u; cnt = 0u; mine = 0u;
#pragma unroll
        for (unsigned j = 0; j < 16; ++j) { const unsigned c = xb_ld(&bar[XB_XCNT(j)]); sum += c; cnt += (c > 0u) ? 1u : 0u; mine = (j == x) ? c : mine; }
        if (sum == G) break;
        __builtin_amdgcn_s_sleep(1);
        if ((++sp & 255u) == 0u) { if (xb_ld(&bar[XB_TMO])) break; if (sp > XB_SPIN_CAP) { atomicAdd(&bar[XB_TMO], 1u); break; } }
    }
    nloc = mine > 0u ? mine : 1u; nx = cnt > 0u ? cnt : 1u;
}

__device__ __forceinline__ void xcd_barrier(const XcdBarrier& b) {
    asm volatile("s_waitcnt vmcnt(0)" ::: "memory");
    __syncthreads();
    if (threadIdx.x == 0) {
        unsigned* bar = b.bar;
        __builtin_amdgcn_s_waitcnt(0);
        unsigned nloc = b.st[0], nx = b.st[1];
        if (nloc == 0u) { xcd_barrier_complete(bar, b.x, nloc, nx); b.st[0] = nloc; b.st[1] = nx; }
        const unsigned old = xb_add(&bar[XB_XSUB(b.x)], 1u);
        const unsigned gen = old / nloc;
        if (old + 1u == (gen + 1u) * nloc) {
            __builtin_amdgcn_fence(__ATOMIC_RELEASE, "agent");
            asm volatile("s_waitcnt vmcnt(0)" ::: "memory");
            const unsigned og = xb_add(&bar[XB_TOP], 1u);
            const unsigned tg = og / nx;
            if (og + 1u == (tg + 1u) * nx) xb_add(&bar[XB_TOPGEN], 1u);
            else XB_SPIN(xb_ld(&bar[XB_TOPGEN]) == tg, bar);
            __builtin_amdgcn_fence(__ATOMIC_ACQUIRE, "agent");
            xb_add(&bar[XB_XGEN(b.x)], 1u);
            asm volatile("s_waitcnt vmcnt(0)" ::: "memory");
        } else {
            XB_SPIN(xb_ld(&bar[XB_XGEN(b.x)]) == gen, bar);
            __builtin_amdgcn_fence(__ATOMIC_ACQUIRE, "agent");
            asm volatile("s_waitcnt vmcnt(0)" ::: "memory");
        }
    }
    __syncthreads();
}

constexpr int NWAVES = 8;
constexpr int DM = 1024, NZ = 3072;
constexpr int MP = 32768, MS = 512, MROWS = MP + MS, MALL = MROWS + 1024;
constexpr int ZC_CB = 0, ZC_CC = 384, ZC_CH = 768, ZC_CZ = 1152, ZC_Q = 1536, ZC_SZ = 1920, ZC_MQ = 2304, ZC_MZ = 2560, ZC_K = 2816, ZC_V = 2944;
constexpr float RMS_EPS = 1e-6f;
constexpr float LOG2E = 1.4426950408889634f;
using pg8::OFF_Y; using pg8::OFF_CP; using pg8::OFF_KP; using pg8::OFF_VP; using pg8::OFF_MKP; using pg8::OFF_MVP; using pg8::OFF_CS; using pg8::OFF_KS; using pg8::OFF_VS;
constexpr size_t MiB = 1u << 20;
constexpr size_t WS_CTL = 0, CTL_ZERO_BYTES = 1 * MiB;
constexpr size_t WS_WT = 2 * MiB;
constexpr size_t WS_WOT = 9 * MiB;
constexpr size_t WS_MK = 11 * MiB;
constexpr size_t WS_MVT = 11 * MiB + 512 * 1024;
constexpr size_t WS_VT = 12 * MiB;
constexpr size_t WS_XN = 20 * MiB;
constexpr size_t WS_Z = 88 * MiB;
constexpr size_t WS_Y = 284 * MiB;
constexpr size_t WS_END = 350 * MiB;
constexpr int CW_BAR = 4096;
constexpr int RING_BYTES = 131072, LDSCTL_OFF = RING_BYTES, MISC_OFF = LDSCTL_OFF + 320, LDS_BYTES = 147456;

typedef float f32x16 __attribute__((ext_vector_type(16)));
typedef short s16x4 __attribute__((ext_vector_type(4)));
typedef unsigned u32x2 __attribute__((ext_vector_type(2)));

__device__ __forceinline__ float wave_sum(float v) {
#pragma unroll
    for (int o = 1; o < 64; o <<= 1) v += __shfl_xor(v, o);
    return v;
}
__device__ __forceinline__ unsigned cvtpk(float lo, float hi) { unsigned r; asm("v_cvt_pk_bf16_f32 %0, %1, %2" : "=v"(r) : "v"(lo), "v"(hi)); return r; }
__device__ __forceinline__ float bflo(unsigned w) { return __uint_as_float(w << 16); }
__device__ __forceinline__ float bfhi(unsigned w) { return __uint_as_float(w & 0xffff0000u); }
__device__ __forceinline__ float silu_f(float x) { return x * __builtin_amdgcn_rcpf(1.0f + __builtin_amdgcn_exp2f(-x * LOG2E)); }
__device__ __forceinline__ int crow(int r, int hi) { return (r & 3) + 8 * (r >> 2) + 4 * hi; }

__device__ __forceinline__ int newcol(int n0) {
    if (n0 < 1920) return n0;
    if (n0 < 2048) return n0 - 1920 + ZC_K;
    if (n0 < 2176) return n0 - 2048 + ZC_V;
    if (n0 < 2560) return n0 - 2176 + ZC_SZ;
    if (n0 < 2816) return n0 - 2560 + ZC_MQ;
    return n0 - 2816 + ZC_MZ;
}
__device__ __forceinline__ void p0_transpose_item(const float* W, const float* g, int K, int N, bf16* WT, int dst_row0, LAS float* scr, int kb, int n0, int lane) {
    const int k0 = 64 * kb;
#pragma unroll 8
    for (int i = 0; i < 32; ++i) { const int kk = 2 * i + (lane >> 5); const float gv = g ? g[k0 + kk] : 1.0f; scr[kk * 33 + (lane & 31)] = W[(size_t)(k0 + kk) * N + n0 + (lane & 31)] * gv; }
    LDS_WAIT(); asm volatile("" ::: "memory");
    const int c = lane & 7;
#pragma unroll
    for (int j = 0; j < 4; ++j) { const int n = (lane >> 3) + 8 * j; const LAS float* s = scr + (8 * c) * 33 + n;
        v4u o; o.x = pk2(s[0 * 33], s[1 * 33]); o.y = pk2(s[2 * 33], s[3 * 33]); o.z = pk2(s[4 * 33], s[5 * 33]); o.w = pk2(s[6 * 33], s[7 * 33]);
        *(GAS v4u*)(WT + (size_t)(dst_row0 + n) * K + k0 + 8 * c) = o; }
    LDS_WAIT(); asm volatile("" ::: "memory");
}
__device__ __forceinline__ void rms_row_to_bf16(const float* xrow, bf16* orow, int lane) {
    const GAS f32x4* xr = (const GAS f32x4*)xrow + lane;
    f32x4 v[4]; float s = 0.f;
#pragma unroll
    for (int j = 0; j < 4; ++j) { v[j] = xr[64 * j]; s += (v[j].x * v[j].x + v[j].y * v[j].y) + (v[j].z * v[j].z + v[j].w * v[j].w); }
    const float rstd = 1.f / sqrtf(wave_sum(s) * (1.f / DM) + RMS_EPS);
    GAS unsigned long long* o8 = (GAS unsigned long long*)orow + lane;
#pragma unroll
    for (int j = 0; j < 4; ++j) o8[64 * j] = (unsigned long long)cvtpk(v[j].x * rstd, v[j].y * rstd) | ((unsigned long long)cvtpk(v[j].z * rstd, v[j].w * rstd) << 32);
}

struct KvBf16 {
    const bf16* kbase; long kpitch; const bf16* vtbase; long vpitch; int kt_min;
    __device__ __forceinline__ bool tile_ok(int kt) const { return kt >= kt_min; }
    __device__ __forceinline__ bf16x8 kfrag(int kt, int s, int r32, int hi) const {
        return *(const bf16x8*)(kbase + (long)(32 * kt + r32) * kpitch + 16 * s + 8 * hi);
    }
    __device__ __forceinline__ bf16x8 vfrag(int kt, int s2, int dt, int r32, int hi) const {
        const bf16* p = vtbase + (long)(32 * dt + r32) * vpitch + 32 * kt + 16 * s2 + 4 * hi;
        const s16x4 a = *(const s16x4*)p, b = *(const s16x4*)(p + 8);
        return (bf16x8){a[0], a[1], a[2], a[3], b[0], b[1], b[2], b[3]};
    }
};
struct KvF32 {
    const float* k0; const float* k1; const float* v0; const float* v1; int pitch, n0, ntot;
    __device__ __forceinline__ bool tile_ok(int) const { return true; }
    __device__ __forceinline__ const float* row(const float* b0, const float* b1, int j) const { return j < n0 ? b0 + (long)j * pitch : (j < ntot ? b1 + (long)(j - n0) * pitch : nullptr); }
    __device__ __forceinline__ bf16x8 kfrag(int kt, int s, int r32, int hi) const {
        const float* p = row(k0, k1, 32 * kt + r32);
        f32x4 a = {0.f, 0.f, 0.f, 0.f}, b = a;
        if (p) { a = *(const f32x4*)(p + 16 * s + 8 * hi); b = *(const f32x4*)(p + 16 * s + 8 * hi + 4); }
        const unsigned w0 = cvtpk(a[0], a[1]), w1 = cvtpk(a[2], a[3]), w2 = cvtpk(b[0], b[1]), w3 = cvtpk(b[2], b[3]);
        return __builtin_bit_cast(bf16x8, (v4u){w0, w1, w2, w3});
    }
    __device__ __forceinline__ bf16x8 vfrag(int kt, int s2, int dt, int r32, int hi) const {
        float v[8];
#pragma unroll
        for (int e = 0; e < 8; ++e) { const float* p = row(v0, v1, 32 * kt + 16 * s2 + 8 * (e >> 2) + 4 * hi + (e & 3)); v[e] = p ? p[32 * dt + r32] : 0.f; }
        const unsigned w0 = cvtpk(v[0], v[1]), w1 = cvtpk(v[2], v[3]), w2 = cvtpk(v[4], v[5]), w3 = cvtpk(v[6], v[7]);
        return __builtin_bit_cast(bf16x8, (v4u){w0, w1, w2, w3});
    }
};

template <int NT, bool MASK, class KV>
__device__ __forceinline__ void attn_job(const KV& kv, const bf16* qptr, int qi, float slope2, float sink2, const bf16* gptr, bf16* yptr, int r32, int hi) {
    bf16x8 qf[4];
#pragma unroll
    for (int s = 0; s < 4; ++s) qf[s] = qptr ? *(const bf16x8*)(qptr + 16 * s + 8 * hi) : (bf16x8){0, 0, 0, 0, 0, 0, 0, 0};
    const float sc2 = 0.125f * LOG2E;
    float m_run = MASK ? sink2 : -3.0e38f, l_run = 0.f;
    f32x16 o0 = {0.f, 0.f, 0.f, 0.f, 0.f, 0.f, 0.f, 0.f, 0.f, 0.f, 0.f, 0.f, 0.f, 0.f, 0.f, 0.f}, o1 = o0;
#pragma unroll 1
    for (int kt = 0; kt < NT; ++kt) {
        if (!kv.tile_ok(kt)) continue;
        f32x16 sa = {0.f, 0.f, 0.f, 0.f, 0.f, 0.f, 0.f, 0.f, 0.f, 0.f, 0.f, 0.f, 0.f, 0.f, 0.f, 0.f};
#pragma unroll
        for (int s = 0; s < 4; ++s) sa = __builtin_amdgcn_mfma_f32_32x32x16_bf16(kv.kfrag(kt, s, r32, hi), qf[s], sa, 0, 0, 0);
        float tmax = -3.0e38f;
#pragma unroll
        for (int r = 0; r < 16; ++r) {
            float v = sa[r] * sc2;
            if (MASK) { const int dist = 128 + qi - (32 * kt + crow(r, hi)); v = (dist >= 0 && dist < 128) ? v - slope2 * (float)dist : -1.0e30f; }
            sa[r] = v; tmax = fmaxf(tmax, v);
        }
        tmax = fmaxf(tmax, __shfl_xor(tmax, 32));
        const float m_new = fmaxf(m_run, tmax), alpha = __builtin_amdgcn_exp2f(m_run - m_new);
        m_run = m_new; l_run *= alpha;
#pragma unroll
        for (int r = 0; r < 16; ++r) { o0[r] *= alpha; o1[r] *= alpha; }
        float p[16];
#pragma unroll
        for (int r = 0; r < 16; ++r) { p[r] = __builtin_amdgcn_exp2f(sa[r] - m_new); l_run += p[r]; }
#pragma unroll
        for (int s2 = 0; s2 < 2; ++s2) {
            const unsigned w0 = cvtpk(p[8 * s2 + 0], p[8 * s2 + 1]), w1 = cvtpk(p[8 * s2 + 2], p[8 * s2 + 3]), w2 = cvtpk(p[8 * s2 + 4], p[8 * s2 + 5]), w3 = cvtpk(p[8 * s2 + 6], p[8 * s2 + 7]);
            const bf16x8 pf = __builtin_bit_cast(bf16x8, (v4u){w0, w1, w2, w3});
            o0 = __builtin_amdgcn_mfma_f32_32x32x16_bf16(kv.vfrag(kt, s2, 0, r32, hi), pf, o0, 0, 0, 0);
            o1 = __builtin_amdgcn_mfma_f32_32x32x16_bf16(kv.vfrag(kt, s2, 1, r32, hi), pf, o1, 0, 0, 0);
        }
    }
    float sum = l_run + __shfl_xor(l_run, 32);
    if (MASK) sum += __builtin_amdgcn_exp2f(sink2 - m_run);
    const float inv = 1.0f / sum;
    if (yptr) {
#pragma unroll
        for (int dt = 0; dt < 2; ++dt) {
#pragma unroll
            for (int g4 = 0; g4 < 4; ++g4) {
                const int d = 32 * dt + 8 * g4 + 4 * hi;
                const u32x2 gw = *(const u32x2*)(gptr + d);
                const float q0 = dt ? o1[4 * g4 + 0] : o0[4 * g4 + 0], q1 = dt ? o1[4 * g4 + 1] : o0[4 * g4 + 1], q2 = dt ? o1[4 * g4 + 2] : o0[4 * g4 + 2], q3 = dt ? o1[4 * g4 + 3] : o0[4 * g4 + 3];
                const float y0 = q0 * inv * silu_f(bflo(gw.x)), y1 = q1 * inv * silu_f(bfhi(gw.x));
                const float y2 = q2 * inv * silu_f(bflo(gw.y)), y3 = q3 * inv * silu_f(bfhi(gw.y));
                u32x2 w; w.x = cvtpk(y0, y1); w.y = cvtpk(y2, y3);
                *(u32x2*)(yptr + d) = w;
            }
        }
    }
}

__device__ __forceinline__ float alibi_slope2(int h) { return __builtin_amdgcn_exp2f(-8.0f * (float)(h + 1) / 6.0f) * LOG2E; }

struct Args { const float* in[17]; float* out; unsigned char* ws; };

__device__ __forceinline__ void p2_mixers(const Args& a, int G, int c, int tid, int lane, int wave) {
    const bf16* Z = (const bf16*)(a.ws + WS_Z); bf16* Y = (bf16*)(a.ws + WS_Y);
    const bf16* VT = (const bf16*)(a.ws + WS_VT); const bf16* MK = (const bf16*)(a.ws + WS_MK); const bf16* MVT = (const bf16*)(a.ws + WS_MVT);
    const float* conv_w = a.in[11]; const float* sinks = a.in[12];
    const int r32 = lane & 31, hi = lane >> 5;
    if (wave < 3) {
        for (int sj = c * 3 + wave; sj < 768; sj += G * 3) {
            if (sj < 256) {
                const int b = sj >> 1, kvh = sj & 1;
                KvF32 kv; kv.pitch = 128; kv.n0 = 128; kv.ntot = 132;
                kv.k0 = a.in[4] + (size_t)b * 16384 + kvh * 64; kv.k1 = a.out + OFF_KS + (size_t)(b * 128 + 124) * 128 + kvh * 64;
                kv.v0 = a.in[5] + (size_t)b * 16384 + kvh * 64; kv.v1 = a.out + OFF_VS + (size_t)(b * 128 + 124) * 128 + kvh * 64;
                const bool ok = r32 < 12; const int g = r32 >> 2, tq = r32 & 3, hq = kvh * 3 + (ok ? g : 0);
                const size_t row = (size_t)MP + b * 4 + tq;
                const bf16* qp = ok ? Z + row * NZ + ZC_Q + hq * 64 : nullptr;
                attn_job<5, true, KvF32>(kv, qp, tq, alibi_slope2(hq), sinks[hq] * LOG2E, Z + row * NZ + ZC_SZ + hq * 64, ok ? Y + row * DM + 384 + hq * 64 : nullptr, r32, hi);
            } else {
                const int mj = sj - 256, b = mj >> 2, hm = mj & 3;
                KvF32 kv; kv.pitch = 256; kv.n0 = 256; kv.ntot = 256;
                kv.k0 = a.in[6] + (size_t)b * 65536 + hm * 64; kv.k1 = kv.k0; kv.v0 = a.in[7] + (size_t)b * 65536 + hm * 64; kv.v1 = kv.v0;
                const bool ok = r32 < 4; const int tq = r32 & 3;
                const size_t row = (size_t)MP + b * 4 + tq;
                const bf16* qp = ok ? Z + row * NZ + ZC_MQ + hm * 64 : nullptr;
                attn_job<8, false, KvF32>(kv, qp, 0, 0.f, 0.f, Z + row * NZ + ZC_MZ + hm * 64, ok ? Y + row * DM + 768 + hm * 64 : nullptr, r32, hi);
            }
        }
    }
    for (int it = c * 512 + tid; it < 128 * 48; it += G * 512) {
        const int b = it / 48, c0 = (it % 48) * 8;
        float w0[8], w1[8], w2[8], up2[8], up1[8];
#pragma unroll
        for (int e = 0; e < 8; ++e) { w0[e] = conv_w[c0 + e]; w1[e] = conv_w[384 + c0 + e]; w2[e] = conv_w[768 + c0 + e]; up2[e] = a.in[3][(size_t)(b * 2 + 0) * 384 + c0 + e]; up1[e] = a.in[3][(size_t)(b * 2 + 1) * 384 + c0 + e]; }
        for (int t = 0; t < 4; ++t) {
            const size_t row = (size_t)MP + b * 4 + t; const bf16* zr = Z + row * NZ + c0;
            const v4u cb = *(const v4u*)(zr + ZC_CB), cc = *(const v4u*)(zr + ZC_CC), ch = *(const v4u*)(zr + ZC_CH), cz = *(const v4u*)(zr + ZC_CZ);
            float u[8], y[8];
#pragma unroll
            for (int e = 0; e < 4; ++e) { u[2 * e] = bflo(cc[e]) * bflo(ch[e]); u[2 * e + 1] = bfhi(cc[e]) * bfhi(ch[e]); }
#pragma unroll
            for (int e = 0; e < 8; ++e) { const float cv = w0[e] * up2[e] + w1[e] * up1[e] + w2[e] * u[e];
                const float cbv = (e & 1) ? bfhi(cb[e >> 1]) : bflo(cb[e >> 1]), czv = (e & 1) ? bfhi(cz[e >> 1]) : bflo(cz[e >> 1]);
                y[e] = cbv * cv * silu_f(czv); up2[e] = up1[e]; up1[e] = u[e]; }
            v4u w; w.x = cvtpk(y[0], y[1]); w.y = cvtpk(y[2], y[3]); w.z = cvtpk(y[4], y[5]); w.w = cvtpk(y[6], y[7]);
            *(v4u*)(Y + row * DM + c0) = w;
            if (t >= 2) { float* sp = a.out + OFF_CS + (size_t)(b * 2 + (t - 2)) * 384 + c0;
                *(f32x4*)sp = (f32x4){u[0], u[1], u[2], u[3]}; *(f32x4*)(sp + 4) = (f32x4){u[4], u[5], u[6], u[7]}; }
        }
    }
    for (int unit = c; unit < 256; unit += G) {
        const int b = unit >> 6, nb = unit & 63;
        const size_t row0 = (size_t)b * 8192 + nb * 128;
        for (int jj = wave; jj < 40; jj += 8) {
            if (jj < 24) {
                const int hq = jj >> 2, qs = jj & 3, kvh = hq / 3;
                const size_t row = row0 + qs * 32 + r32;
                KvBf16 kv;
                kv.kbase = Z + ((long)row0 - 128 + 32 * qs) * NZ + ZC_K + kvh * 64; kv.kpitch = NZ;
                kv.vtbase = VT + (size_t)(b * 128 + kvh * 64) * 8192 + (nb * 128 - 128 + 32 * qs); kv.vpitch = 8192;
                kv.kt_min = (nb == 0) ? (4 - qs) : 0;
                attn_job<5, true, KvBf16>(kv, Z + row * NZ + ZC_Q + hq * 64, r32, alibi_slope2(hq), sinks[hq] * LOG2E, Z + row * NZ + ZC_SZ + hq * 64, Y + row * DM + 384 + hq * 64, r32, hi);
            } else {
                const int hm = (jj - 24) >> 2, qs = (jj - 24) & 3;
                const size_t row = row0 + qs * 32 + r32;
                KvBf16 kv;
                kv.kbase = MK + (size_t)b * 256 * 256 + hm * 64; kv.kpitch = 256;
                kv.vtbase = MVT + (size_t)(b * 256 + hm * 64) * 256; kv.vpitch = 256; kv.kt_min = 0;
                attn_job<8, false, KvBf16>(kv, Z + row * NZ + ZC_MQ + hm * 64, 0, 0.f, 0.f, Z + row * NZ + ZC_MZ + hm * 64, Y + row * DM + 768 + hm * 64, r32, hi);
            }
        }
        if (tid < 384) {
            const int c0 = (tid % 48) * 8, tg = tid / 48; const int t0 = nb * 128 + tg * 16;
            float w0[8], w1[8], w2[8], up2[8], up1[8];
#pragma unroll
            for (int e = 0; e < 8; ++e) { w0[e] = conv_w[c0 + e]; w1[e] = conv_w[384 + c0 + e]; w2[e] = conv_w[768 + c0 + e]; up2[e] = 0.f; up1[e] = 0.f; }
            if (t0 >= 2) {
                const bf16* z2 = Z + ((size_t)b * 8192 + t0 - 2) * NZ + c0; const bf16* z1 = z2 + NZ;
                const v4u cc2 = *(const v4u*)(z2 + ZC_CC), ch2 = *(const v4u*)(z2 + ZC_CH), cc1 = *(const v4u*)(z1 + ZC_CC), ch1 = *(const v4u*)(z1 + ZC_CH);
#pragma unroll
                for (int e = 0; e < 4; ++e) { up2[2 * e] = bflo(cc2[e]) * bflo(ch2[e]); up2[2 * e + 1] = bfhi(cc2[e]) * bfhi(ch2[e]); up1[2 * e] = bflo(cc1[e]) * bflo(ch1[e]); up1[2 * e + 1] = bfhi(cc1[e]) * bfhi(ch1[e]); }
            }
            for (int tt = 0; tt < 16; ++tt) {
                const int t = t0 + tt; const size_t row = (size_t)b * 8192 + t; const bf16* zr = Z + row * NZ + c0;
                const v4u cb = *(const v4u*)(zr + ZC_CB), cc = *(const v4u*)(zr + ZC_CC), ch = *(const v4u*)(zr + ZC_CH), cz = *(const v4u*)(zr + ZC_CZ);
                float u[8], y[8];
#pragma unroll
                for (int e = 0; e < 4; ++e) { u[2 * e] = bflo(cc[e]) * bflo(ch[e]); u[2 * e + 1] = bfhi(cc[e]) * bfhi(ch[e]); }
#pragma unroll
                for (int e = 0; e < 8; ++e) { const float cv = w0[e] * up2[e] + w1[e] * up1[e] + w2[e] * u[e];
                    const float cbv = (e & 1) ? bfhi(cb[e >> 1]) : bflo(cb[e >> 1]), czv = (e & 1) ? bfhi(cz[e >> 1]) : bflo(cz[e >> 1]);
                    y[e] = cbv * cv * silu_f(czv); up2[e] = up1[e]; up1[e] = u[e]; }
                v4u w; w.x = cvtpk(y[0], y[1]); w.y = cvtpk(y[2], y[3]); w.z = cvtpk(y[4], y[5]); w.w = cvtpk(y[6], y[7]);
                *(v4u*)(Y + row * DM + c0) = w;
                if (t >= 8190) { float* sp = a.out + OFF_CP + (size_t)(b * 2 + (t - 8190)) * 384 + c0;
                    *(f32x4*)sp = (f32x4){u[0], u[1], u[2], u[3]}; *(f32x4*)(sp + 4) = (f32x4){u[4], u[5], u[6], u[7]}; }
            }
        }
    }
}

__global__ void __launch_bounds__(NWAVES * 64, 2) mega_fwd(Args a) {
    extern __shared__ __attribute__((aligned(16))) unsigned char lds[];
    LAS unsigned char* L = (LAS unsigned char*)lds;
    volatile LAS unsigned* MISC = (volatile LAS unsigned*)(L + MISC_OFF);
    const int tid = threadIdx.x, lane = tid & 63, wave = __builtin_amdgcn_readfirstlane(tid >> 6);
    const int G = gridDim.x, c = blockIdx.x;
    for (int u = tid; u < (LDS_BYTES - LDSCTL_OFF) / 4; u += NWAVES * 64) ((LAS unsigned*)(L + LDSCTL_OFF))[u] = 0u;
    __syncthreads();
    gu32* ctl = (gu32*)(a.ws + WS_CTL);
    XcdBarrier bar = xcd_barrier_post((unsigned*)(ctl + CW_BAR), MISC + 8);

    bf16* WT = (bf16*)(a.ws + WS_WT); bf16* WOT = (bf16*)(a.ws + WS_WOT); bf16* XN = (bf16*)(a.ws + WS_XN);
    bf16* Zb = (bf16*)(a.ws + WS_Z); bf16* Yb = (bf16*)(a.ws + WS_Y); bf16* YRAW = (bf16*)(a.ws + WS_XN);

    {
        LAS float* scr = (LAS float*)(L + wave * 16384);
        const int gw = c * NWAVES + wave, NGW = G * NWAVES;
        constexpr int I_IN = 16 * 96, I_OUT = 16 * 32, I_MK = 16 * 8;
        for (int it = gw; it < I_IN + I_OUT + 2 * I_MK; it += NGW) {
            int r = it;
            if (r < I_IN) { const int kb = r / 96, n0 = 32 * (r % 96); p0_transpose_item(a.in[10], a.in[8], 1024, 3072, WT, newcol(n0), scr, kb, n0, lane); continue; } r -= I_IN;
            if (r < I_OUT) { const int kb = r / 32, n0 = 32 * (r % 32); p0_transpose_item(a.in[16], nullptr, 1024, 1024, WOT, n0, scr, kb, n0, lane); continue; } r -= I_OUT;
            if (r < I_MK) { const int kb = r / 8, n0 = 32 * (r % 8); p0_transpose_item(a.in[14], a.in[13], 1024, 256, WT, 3072 + n0, scr, kb, n0, lane); continue; } r -= I_MK;
            { const int kb = r / 8, n0 = 32 * (r % 8); p0_transpose_item(a.in[15], a.in[13], 1024, 256, WT, 3328 + n0, scr, kb, n0, lane); }
        }
        for (int m = gw; m < MALL; m += NGW) {
            const float* src = m < MP ? a.in[0] + (size_t)m * DM : (m < MROWS ? a.in[1] + (size_t)(m - MP) * DM : a.in[2] + (size_t)(m - MROWS) * DM);
            rms_row_to_bf16(src, XN + (size_t)m * DM, lane);
        }
        for (int i = c * 512 + tid; i < 2 * 128 * 3968; i += G * 512) {
            const int which = i / (128 * 3968), r = i % (128 * 3968), b = r / 3968, e = r % 3968;
            const f32x4 v = *((const f32x4*)(a.in[4 + which] + (size_t)b * 16384 + 512) + e);
            *((f32x4*)(a.out + (which ? OFF_VS : OFF_KS) + (size_t)b * 16384) + e) = v;
        }
    }
    xcd_barrier(bar);
    {
        pg8::Gemm g{XN, WT, MALL, 3584, 1024}; pg8::OrderP1 S; S.init(G, c);
        pg8::EpiZ E{Zb, (bf16*)(a.ws + WS_VT), (bf16*)(a.ws + WS_MK), (bf16*)(a.ws + WS_MVT), a.out};
        pg8::gemm_phase<pg8::EpiZ, pg8::OrderP1, true, true>(L, g, S, E);
    }
    xcd_barrier(bar);
#ifndef NO_P2
    p2_mixers(a, G, c, tid, lane, wave);
#endif
    xcd_barrier(bar);
    {
        pg8::Gemm g{Yb, WOT, MROWS, 1024, 1024}; pg8::StaticOrder S; S.init(MROWS, 1024, G, c);
        pg8::EpiPlain E{YRAW, 1024};
        pg8::gemm_phase<pg8::EpiPlain, pg8::StaticOrder, true, true>(L, g, S, E);
    }
    xcd_barrier(bar);
    {
        const int gw = c * NWAVES + wave, NGW = G * NWAVES;
        const float* gp = a.in[9];
        f32x4 gv[4];
#pragma unroll
        for (int j = 0; j < 4; ++j) gv[j] = *((const f32x4*)gp + lane + 64 * j);
        for (int m = gw; m < MROWS; m += NGW) {
            const float* xs = m < MP ? a.in[0] + (size_t)m * DM : a.in[1] + (size_t)(m - MP) * DM;
            const u32x2* yr = (const u32x2*)(YRAW + (size_t)m * DM) + lane;
            float yv[4][4]; float s = 0.f;
#pragma unroll
            for (int j = 0; j < 4; ++j) { const u32x2 w = yr[64 * j]; yv[j][0] = bflo(w.x); yv[j][1] = bfhi(w.x); yv[j][2] = bflo(w.y); yv[j][3] = bfhi(w.y);
                s += (yv[j][0] * yv[j][0] + yv[j][1] * yv[j][1]) + (yv[j][2] * yv[j][2] + yv[j][3] * yv[j][3]); }
            const float rstd = 1.f / sqrtf(wave_sum(s) * (1.f / DM) + RMS_EPS);
            float* orow = a.out + OFF_Y + (size_t)m * DM;
#pragma unroll
            for (int j = 0; j < 4; ++j) { const f32x4 xv = *((const f32x4*)xs + lane + 64 * j);
                f32x4 o; o.x = xv.x + yv[j][0] * rstd * gv[j].x; o.y = xv.y + yv[j][1] * rstd * gv[j].y; o.z = xv.z + yv[j][2] * rstd * gv[j].z; o.w = xv.w + yv[j][3] * rstd * gv[j].w;
                *((f32x4*)orow + lane + 64 * j) = o; }
        }
    }
}

extern "C" void kernel_launch(void* const* d_in, const int* in_sizes, int n_in, void* d_out, int out_size, void* d_ws, size_t ws_size, hipStream_t stream) {
    static int grid = 0;
    if (grid == 0) {
        if (n_in != 17 || ws_size < WS_END) { fprintf(stderr, "kernel_launch: unexpected inputs (n_in %d, ws %zu)\n", n_in, ws_size); grid = -1; return; }
        int dev = 0, cus = 0, per_cu = 0;
        hipGetDevice(&dev); hipDeviceGetAttribute(&cus, hipDeviceAttributeMultiprocessorCount, dev);
        hipFuncSetAttribute((const void*)mega_fwd, hipFuncAttributeMaxDynamicSharedMemorySize, LDS_BYTES);
        if (hipOccupancyMaxActiveBlocksPerMultiprocessor(&per_cu, (const void*)mega_fwd, NWAVES * 64, LDS_BYTES) != hipSuccess || per_cu < 1) { fprintf(stderr, "kernel_launch: occupancy query says %d\n", per_cu); (void)hipGetLastError(); per_cu = 1; }
        grid = cus;
    }
    if (grid < 0) return;
    hipMemsetAsync((char*)d_ws + WS_CTL, 0, CTL_ZERO_BYTES, stream);
    Args a{};
    for (int i = 0; i < 17; ++i) a.in[i] = (const float*)d_in[i];
    a.out = (float*)d_out; a.ws = (unsigned char*)d_ws;
    hipLaunchKernelGGL(mega_fwd, dim3(grid), dim3(NWAVES * 64), LDS_BYTES, stream, a);
}
```

```cpp
#include <hip/hip_runtime.h>
#include <cstdio>
#include <cstdint>
namespace pg8 {
#define PG8_LAS __attribute__((address_space(3)))
typedef unsigned short bf16_t;
typedef short bf16x8 __attribute__((ext_vector_type(8)));
typedef float f32x4 __attribute__((ext_vector_type(4)));
typedef unsigned u32x4 __attribute__((ext_vector_type(4)));
constexpr int BM = 256, BK = 64, HALF = 128, HTB = HALF * BK * 2  , STAGE_BYTES = 8 * HTB, NXCD = 8, WGM = 8;

__host__ __device__ __forceinline__ int lds_byte(int r, int c) { const int st = (r >> 4) * 2 + (c >> 5), rr = r & 15, cc = c & 31, ob = rr * 64 + cc * 2; return st * 1024 + (ob ^ (((ob >> 9) & 1) << 5)); }
__host__ __device__ __forceinline__ void stage_rc(int b, int& R, int& C) { const int st = b / 1024, sb = b % 1024, swz = sb ^ (((sb >> 9) & 1) << 5); R = (st >> 1) * 16 + swz / 64; C = (st & 1) * 32 + (swz % 64) / 2; }
__host__ __device__ __forceinline__ int perm32(int rho) { const int n = rho >> 4, i = rho & 15; return 8 * (i >> 2) + 4 * n + (i & 3); }

struct Unit { int pm, pn; };
struct Gemm { const bf16_t* A; const bf16_t* Bt; int M, N, K; };

struct StaticOrder {
    int nM, nN, nwg, G, c;
    __host__ __device__ void init(int M, int N, int G_, int c_) { nM = M / BM; nN = N / BM; nwg = nM * nN; G = G_; c = c_; }
    __host__ __device__ bool next(int i, Unit& u) const {
        const long L = (long)i * G + c; if (L >= nwg) return false;
        int wgid = (int)L; { const int q = nwg / NXCD, r = nwg % NXCD, xcd = wgid % NXCD, off = wgid / NXCD; wgid = (xcd < r ? xcd * (q + 1) : r * (q + 1) + (xcd - r) * q) + off; }
        const int nig = WGM * nN, gid = wgid / nig, fm = gid * WGM, gsz = (nM - fm) < WGM ? (nM - fm) : WGM;
        u.pm = fm + ((wgid % nig) % gsz); u.pn = (wgid % nig) / gsz; return true;
    }
    __device__ __forceinline__ void a_ready(const Unit&) const {}
    __device__ __forceinline__ void done(const Unit&) const {}
};

__device__ __forceinline__ unsigned cvt_pk_bf16(float lo, float hi) { unsigned r; asm volatile("v_cvt_pk_bf16_f32 %0, %1, %2" : "=v"(r) : "v"(lo), "v"(hi)); return r; }
typedef float f32x2 __attribute__((ext_vector_type(2)));
typedef unsigned u32x2 __attribute__((ext_vector_type(2)));
constexpr long OFF_Y = 0, OFF_CP = 34078720, OFF_KP = 34081792, OFF_VP = 34147328, OFF_MKP = 34212864, OFF_MVP = 34475008, OFF_CS = 34737152, OFF_KS = 34835456, OFF_VS = 36932608;
struct EpiPlain {
    static constexpr bool PERM = true, AFTER_DRAIN = false;
    bf16_t* O; int ldc;
    __device__ __forceinline__ void operator()(const f32x4 (&acc)[2][2][4][2], const Unit& u, int wr, int wc, int fr, int fq) const {
        const int rowb = u.pm * BM + wr * 64 + fr; const int cw = wc * 32 + 8 * fq;
#pragma unroll
        for (int ai = 0; ai < 2; ++ai)
#pragma unroll
            for (int m = 0; m < 4; ++m) { bf16_t* rp = O + (size_t)(rowb + ai * HALF + m * 16) * ldc + u.pn * BM + cw;
#pragma unroll
                for (int bj = 0; bj < 2; ++bj) { const f32x4 v0 = acc[ai][bj][m][0], v1 = acc[ai][bj][m][1];
                    u32x4 w; w.x = cvt_pk_bf16(v0[0], v0[1]); w.y = cvt_pk_bf16(v0[2], v0[3]); w.z = cvt_pk_bf16(v1[0], v1[1]); w.w = cvt_pk_bf16(v1[2], v1[3]);
                    *(u32x4*)(rp + bj * HALF) = w; } }
    }
};
struct EpiZ {
    static constexpr bool PERM = true, AFTER_DRAIN = false;
    bf16_t* Z; bf16_t* VT; bf16_t* MK; bf16_t* MVT; float* out;
    __device__ __forceinline__ void operator()(const f32x4 (&acc)[2][2][4][2], const Unit& u, int wr, int wc, int fr, int fq) const {
        const int rowb = u.pm * BM + wr * 64 + fr; const int cw = wc * 32 + 8 * fq;
        if (u.pn < 11) {
#pragma unroll
            for (int ai = 0; ai < 2; ++ai)
#pragma unroll
                for (int m = 0; m < 4; ++m) { bf16_t* rp = Z + (size_t)(rowb + ai * HALF + m * 16) * 3072 + u.pn * BM + cw;
#pragma unroll
                    for (int bj = 0; bj < 2; ++bj) { const f32x4 v0 = acc[ai][bj][m][0], v1 = acc[ai][bj][m][1];
                        u32x4 w; w.x = cvt_pk_bf16(v0[0], v0[1]); w.y = cvt_pk_bf16(v0[2], v0[3]); w.z = cvt_pk_bf16(v1[0], v1[1]); w.w = cvt_pk_bf16(v1[2], v1[3]);
                        *(u32x4*)(rp + bj * HALF) = w; } }
        } else if (u.pn == 11) {
#pragma unroll
            for (int ai = 0; ai < 2; ++ai)
#pragma unroll
                for (int m = 0; m < 4; ++m) {
                    const int row = rowb + ai * HALF + m * 16;
                    long so = -1;
                    const bool prompt = row < 32768;
                    const int t = row & 8191, b = row >> 13;
                    if (prompt) { if (t >= 8064) so = (long)(b * 128 + (t - 8064)) * 128 + cw; }
                    else { const int rs = row - 32768; so = (long)((rs >> 2) * 128 + 124 + (rs & 3)) * 128 + cw; }
                    {
                        const f32x4 v0 = acc[ai][0][m][0], v1 = acc[ai][0][m][1];
                        u32x4 w; w.x = cvt_pk_bf16(v0[0], v0[1]); w.y = cvt_pk_bf16(v0[2], v0[3]); w.z = cvt_pk_bf16(v1[0], v1[1]); w.w = cvt_pk_bf16(v1[2], v1[3]);
                        *(u32x4*)(Z + (size_t)row * 3072 + 2816 + cw) = w;
                        if (so >= 0) { float* sp = out + (prompt ? OFF_KP : OFF_KS) + so; *(f32x4*)sp = v0; *(f32x4*)(sp + 4) = v1; }
                    }
                    {
                        const f32x4 v0 = acc[ai][1][m][0], v1 = acc[ai][1][m][1];
                        if (prompt) {
                            const unsigned w0 = cvt_pk_bf16(v0[0], v0[1]), w1 = cvt_pk_bf16(v0[2], v0[3]), w2 = cvt_pk_bf16(v1[0], v1[1]), w3 = cvt_pk_bf16(v1[2], v1[3]);
                            bf16_t* vp = VT + ((size_t)(b * 128 + cw) * 8192 + t);
                            vp[0 * 8192] = (bf16_t)w0; vp[1 * 8192] = (bf16_t)(w0 >> 16); vp[2 * 8192] = (bf16_t)w1; vp[3 * 8192] = (bf16_t)(w1 >> 16);
                            vp[4 * 8192] = (bf16_t)w2; vp[5 * 8192] = (bf16_t)(w2 >> 16); vp[6 * 8192] = (bf16_t)w3; vp[7 * 8192] = (bf16_t)(w3 >> 16);
                        }
                        if (so >= 0) { float* sp = out + (prompt ? OFF_VP : OFF_VS) + so; *(f32x4*)sp = v0; *(f32x4*)(sp + 4) = v1; }
                    }
                }
        } else {
            const bool isk = (u.pn == 12);
#pragma unroll
            for (int ai = 0; ai < 2; ++ai)
#pragma unroll
                for (int m = 0; m < 4; ++m) {
                    const int mrow = rowb + ai * HALF + m * 16 - 33280;
#pragma unroll
                    for (int bj = 0; bj < 2; ++bj) {
                        const f32x4 v0 = acc[ai][bj][m][0], v1 = acc[ai][bj][m][1]; const int col = cw + bj * HALF;
                        float* sp = out + (isk ? OFF_MKP : OFF_MVP) + (long)mrow * 256 + col; *(f32x4*)sp = v0; *(f32x4*)(sp + 4) = v1;
                        const unsigned w0 = cvt_pk_bf16(v0[0], v0[1]), w1 = cvt_pk_bf16(v0[2], v0[3]), w2 = cvt_pk_bf16(v1[0], v1[1]), w3 = cvt_pk_bf16(v1[2], v1[3]);
                        if (isk) { u32x4 w; w.x = w0; w.y = w1; w.z = w2; w.w = w3; *(u32x4*)(MK + (size_t)mrow * 256 + col) = w; }
                        else { bf16_t* vp = MVT + ((size_t)((mrow >> 8) * 256 + col) * 256 + (mrow & 255));
                            vp[0 * 256] = (bf16_t)w0; vp[1 * 256] = (bf16_t)(w0 >> 16); vp[2 * 256] = (bf16_t)w1; vp[3 * 256] = (bf16_t)(w1 >> 16);
                            vp[4 * 256] = (bf16_t)w2; vp[5 * 256] = (bf16_t)(w2 >> 16); vp[6 * 256] = (bf16_t)w3; vp[7 * 256] = (bf16_t)(w3 >> 16); }
                    }
                }
        }
    }
};
struct OrderP1 {
    StaticOrder so; int G, c;
    __host__ __device__ void init(int G_, int c_) { so.init(32768, 3072, G_, c_); G = G_; c = c_; }
    __host__ __device__ bool next(int i, Unit& u) const {
        if (so.next(i, u)) return true;
        const long e = (long)i * G + c - so.nwg; if (e < 0 || e >= 32) return false;
        if (e < 24) { u.pm = 128 + (int)e / 12; u.pn = (int)e % 12; } else { u.pm = 130 + (int)(e - 24) / 2; u.pn = 12 + (int)(e - 24) % 2; }
        return true;
    }
    __device__ __forceinline__ void a_ready(const Unit&) const {}
    __device__ __forceinline__ void done(const Unit&) const {}
};
template <class Epi, class Sched, bool ALIGN_EPI = false, bool SP2 = false>
__device__ __forceinline__ void gemm_phase(PG8_LAS unsigned char* lds, const Gemm g, const Sched& S, const Epi& E) {
    const int tid = threadIdx.x, wid = __builtin_amdgcn_readfirstlane(tid >> 6), lane = tid & 63, wr = wid >> 2, wc = wid & 3, fr = lane & 15, fq = lane >> 4;
    const int K = g.K, nt = K / BK;
    unsigned voffA[2], voffB[2];
#pragma unroll
    for (int i = 0; i < 2; ++i) { int R, C; stage_rc(tid * 16 + i * 8192, R, C); const int Rb = Epi::PERM ? ((R & ~31) + perm32(R & 31)) : R;
        voffA[i] = (unsigned)(R * K + C) * 2u; voffB[i] = (unsigned)(Rb * K + C) * 2u; }
    const size_t kstep = (size_t)(BK * 2);
    const size_t hstep = (size_t)HALF * K * 2;
    const size_t tstep = 2 * hstep;
    const unsigned ldsw = (unsigned)wid * 1024u;
    const int aoff = lds_byte(wr * 64 + fr, fq * 8), boff = lds_byte(wc * 32 + fr, fq * 8);
#define PG8_SA(b, h) (((b) * 2 + (h)) * HTB)
#define PG8_SB(b, h) ((4 + (b) * 2 + (h)) * HTB)
#define PG8_STAGE(bufoff, gbase, voff) do { _Pragma("unroll") for (int _i = 0; _i < 2; ++_i) \
        __builtin_amdgcn_global_load_lds((const unsigned*)((const char*)(gbase) + (voff)[_i]), (PG8_LAS unsigned*)(lds + (bufoff) + ldsw + _i * 8192), 16, 0, 0); } while (0)
#define PG8_LDA(dst, b, h) do { _Pragma("unroll") for (int m = 0; m < 4; ++m) _Pragma("unroll") for (int k = 0; k < 2; ++k) dst[m][k] = *(const PG8_LAS bf16x8*)(lds + PG8_SA(b, h) + aoff + m * 2048 + k * 1024); } while (0)
#define PG8_LDB(dst, b, h) do { _Pragma("unroll") for (int n = 0; n < 2; ++n) _Pragma("unroll") for (int k = 0; k < 2; ++k) dst[n][k] = *(const PG8_LAS bf16x8*)(lds + PG8_SB(b, h) + boff + n * 2048 + k * 1024); } while (0)
#define PG8_MMA(ai, bj, At, Bt) do { __builtin_amdgcn_s_setprio(1); _Pragma("unroll") for (int m = 0; m < 4; ++m) _Pragma("unroll") for (int n = 0; n < 2; ++n) _Pragma("unroll") for (int k = 0; k < 2; ++k) \
        acc[ai][bj][m][n] = __builtin_amdgcn_mfma_f32_16x16x32_bf16(Bt[n][k], At[m][k], acc[ai][bj][m][n], 0, 0, 0); __builtin_amdgcn_s_setprio(0); } while (0)
#define PG8_WAIT_V(n) asm volatile("s_waitcnt vmcnt(" #n ")" ::: "memory")
#define PG8_WAIT_L(n) asm volatile("s_waitcnt lgkmcnt(" #n ")" ::: "memory")
#define PG8_BAR __builtin_amdgcn_s_barrier()
#define PG8_SCHED __builtin_amdgcn_sched_barrier(0)
    Unit cur, nxt; int ui = 0;
    if (!S.next(0, cur)) return;
    f32x4 acc[2][2][4][2];
#pragma unroll
    for (int a = 0; a < 2; ++a)
#pragma unroll
        for (int b = 0; b < 2; ++b)
#pragma unroll
            for (int m = 0; m < 4; ++m)
#pragma unroll
                for (int n = 0; n < 2; ++n) acc[a][b][m][n] = (f32x4){0.f, 0.f, 0.f, 0.f};
    bf16x8 At[4][2], B0[2][2], B1[2][2];
    const char* cA = (const char*)g.A + (size_t)cur.pm * tstep; const char* cB = (const char*)g.Bt + (size_t)cur.pn * tstep;
    S.a_ready(cur);
    if constexpr (SP2) {
        PG8_STAGE(PG8_SB(0, 0), cB, voffB); PG8_STAGE(PG8_SB(0, 1), cB + hstep, voffB); PG8_STAGE(PG8_SA(0, 0), cA, voffA); PG8_STAGE(PG8_SA(0, 1), cA + hstep, voffA);
        if (wr == 1) PG8_BAR;
        PG8_WAIT_V(2); PG8_BAR;
        PG8_STAGE(PG8_SB(1, 0), cB + kstep, voffB); PG8_STAGE(PG8_SA(1, 0), cA + kstep, voffA); PG8_STAGE(PG8_SB(1, 1), cB + hstep + kstep, voffB);
        PG8_WAIT_V(6); PG8_BAR;
    } else {
        PG8_STAGE(PG8_SB(0, 0), cB, voffB); PG8_STAGE(PG8_SA(0, 0), cA, voffA); PG8_STAGE(PG8_SB(0, 1), cB + hstep, voffB); PG8_STAGE(PG8_SA(0, 1), cA + hstep, voffA);
        if (wr == 1) PG8_BAR;
        PG8_WAIT_V(4); PG8_BAR;
        PG8_STAGE(PG8_SB(1, 0), cB + kstep, voffB); PG8_STAGE(PG8_SA(1, 0), cA + kstep, voffA); PG8_STAGE(PG8_SB(1, 1), cB + hstep + kstep, voffB);
        PG8_WAIT_V(6); PG8_BAR;
    }
    for (;;) {
        const bool has_next = S.next(ui + 1, nxt);
        const char* nA = has_next ? (const char*)g.A + (size_t)nxt.pm * tstep : cA; const char* nB = has_next ? (const char*)g.Bt + (size_t)nxt.pn * tstep : cB;
        for (int t = 0; t < nt; t += 2) {
            const bool last = (t == nt - 2);
            const char* a1 = cA + (size_t)(t + 1) * kstep;
            const char* a2 = last ? nA : cA + (size_t)(t + 2) * kstep; const char* b2 = last ? nB : cB + (size_t)(t + 2) * kstep;
            const char* a3 = a2 + kstep; const char* b3 = b2 + kstep;
            if (last && has_next) S.a_ready(nxt);
            if constexpr (SP2) {
            PG8_LDB(B0, 0, 0); PG8_LDB(B1, 0, 1); PG8_SCHED; PG8_LDA(At, 0, 0); PG8_STAGE(PG8_SA(1, 1), a1 + hstep, voffA);
            PG8_WAIT_V(8); PG8_WAIT_L(0); PG8_BAR; PG8_MMA(0, 0, At, B0); PG8_MMA(0, 1, At, B1); PG8_BAR; PG8_SCHED;
            PG8_LDA(At, 0, 1); PG8_STAGE(PG8_SB(0, 0), b2, voffB); PG8_STAGE(PG8_SB(0, 1), b2 + hstep, voffB); PG8_STAGE(PG8_SA(0, 0), a2, voffA);
            PG8_WAIT_V(8); PG8_WAIT_L(0); PG8_BAR; PG8_MMA(1, 0, At, B0); PG8_MMA(1, 1, At, B1); PG8_BAR; PG8_SCHED;
            PG8_LDB(B0, 1, 0); PG8_LDB(B1, 1, 1); PG8_SCHED; PG8_LDA(At, 1, 0); PG8_STAGE(PG8_SA(0, 1), a2 + hstep, voffA);
            PG8_WAIT_V(8); PG8_WAIT_L(0); PG8_BAR; PG8_MMA(0, 0, At, B0); PG8_MMA(0, 1, At, B1); PG8_BAR; PG8_SCHED;
            PG8_LDA(At, 1, 1); PG8_STAGE(PG8_SB(1, 0), b3, voffB); PG8_STAGE(PG8_SB(1, 1), b3 + hstep, voffB); PG8_STAGE(PG8_SA(1, 0), a3, voffA);
            PG8_WAIT_V(8); PG8_WAIT_L(0); PG8_BAR; PG8_MMA(1, 0, At, B0); PG8_MMA(1, 1, At, B1); PG8_BAR; PG8_SCHED;
            } else {
            PG8_LDB(B0, 0, 0); PG8_SCHED; PG8_LDA(At, 0, 0); PG8_STAGE(PG8_SA(1, 1), a1 + hstep, voffA);
            PG8_WAIT_L(8); PG8_BAR; PG8_WAIT_L(0); PG8_MMA(0, 0, At, B0); PG8_BAR; PG8_SCHED;
            PG8_LDB(B1, 0, 1); PG8_STAGE(PG8_SB(0, 0), b2, voffB);
            PG8_BAR; PG8_WAIT_L(0); PG8_MMA(0, 1, At, B1); PG8_BAR;
            PG8_LDA(At, 0, 1); PG8_STAGE(PG8_SA(0, 0), a2, voffA);
            PG8_BAR; PG8_WAIT_L(0); PG8_MMA(1, 0, At, B0); PG8_BAR; PG8_SCHED;
            PG8_STAGE(PG8_SB(0, 1), b2 + hstep, voffB);
            PG8_WAIT_V(6); PG8_BAR; PG8_MMA(1, 1, At, B1); PG8_BAR;
            PG8_LDB(B0, 1, 0); PG8_SCHED; PG8_LDA(At, 1, 0); PG8_STAGE(PG8_SA(0, 1), a2 + hstep, voffA);
            PG8_WAIT_L(8); PG8_BAR; PG8_WAIT_L(0); PG8_MMA(0, 0, At, B0); PG8_BAR; PG8_SCHED;
            PG8_LDB(B1, 1, 1); PG8_STAGE(PG8_SB(1, 0), b3, voffB);
            PG8_BAR; PG8_WAIT_L(0); PG8_MMA(0, 1, At, B1); PG8_BAR;
            PG8_LDA(At, 1, 1); PG8_STAGE(PG8_SA(1, 0), a3, voffA);
            PG8_BAR; PG8_WAIT_L(0); PG8_MMA(1, 0, At, B0); PG8_BAR; PG8_SCHED;
            PG8_STAGE(PG8_SB(1, 1), b3 + hstep, voffB);
            PG8_WAIT_V(6); PG8_BAR; PG8_MMA(1, 1, At, B1); PG8_BAR;
            }
        }
        if constexpr (ALIGN_EPI) { if (wr == 0) PG8_BAR; }
        if constexpr (!Epi::AFTER_DRAIN) { E(acc, cur, wr, wc, fr, fq); S.done(cur); }
        if (!has_next) break;
#pragma unroll
        for (int a = 0; a < 2; ++a)
#pragma unroll
            for (int b = 0; b < 2; ++b)
#pragma unroll
                for (int m = 0; m < 4; ++m)
#pragma unroll
                    for (int n = 0; n < 2; ++n) acc[a][b][m][n] = (f32x4){0.f, 0.f, 0.f, 0.f};
        cur = nxt; cA = nA; cB = nB; ++ui;
        if constexpr (ALIGN_EPI) { if (wr == 1) PG8_BAR; }
    }
    PG8_WAIT_V(0);
    if constexpr (!ALIGN_EPI) { if (wr == 0) PG8_BAR; }
    PG8_BAR;
    if constexpr (Epi::AFTER_DRAIN) { E.fused(acc, cur, wr, wc, fr, fq, lds, wid, lane); S.done(cur); }
#undef PG8_SA
#undef PG8_SB
#undef PG8_STAGE
#undef PG8_LDA
#undef PG8_LDB
#undef PG8_MMA
#undef PG8_WAIT_V
#undef PG8_WAIT_L
#undef PG8_BAR
#undef PG8_SCHED
}
}
#define GAS __attribute__((address_space(1)))
#define LAS __attribute__((address_space(3)))
typedef unsigned short bf16;
typedef unsigned v4u __attribute__((ext_vector_type(4)));
typedef float f32x4 __attribute__((ext_vector_type(4)));
typedef short bf16x8 __attribute__((ext_vector_type(8)));
typedef GAS unsigned gu32;
typedef GAS unsigned long long gu64;
#define RLX_AGENT __ATOMIC_RELAXED, __HIP_MEMORY_SCOPE_AGENT
#define LDS_WAIT() asm volatile("s_waitcnt lgkmcnt(0)" ::: "memory")
#define VM_WAIT() asm volatile("s_waitcnt vmcnt(0)" ::: "memory")
__device__ __forceinline__ unsigned long long rt() { return __builtin_amdgcn_s_memrealtime(); }
__device__ __forceinline__ unsigned f2bf(float f) { unsigned u = __builtin_bit_cast(unsigned, f); return (u + 0x7fffu + ((u >> 16) & 1u)) >> 16; }
__device__ __forceinline__ unsigned pk2(float lo, float hi) { return f2bf(lo) | (f2bf(hi) << 16); }

#define XB_TMO      128
#define XB_XCNT(j)  (256  + 64 * (j))
#define XB_XSUB(j)  (1280 + 64 * (j))
#define XB_XGEN(j)  (2304 + 64 * (j))
#define XB_TOP      3328
#define XB_TOPGEN   3392
#define XCD_BAR_WORDS 3456
#define XB_SPIN_CAP (1u << 18)

__device__ __forceinline__ unsigned xb_ld(unsigned* p)              { return __hip_atomic_load(p, __ATOMIC_RELAXED, __HIP_MEMORY_SCOPE_AGENT); }
__device__ __forceinline__ unsigned xb_add(unsigned* p, unsigned v) { return __hip_atomic_fetch_add(p, v, __ATOMIC_RELAXED, __HIP_MEMORY_SCOPE_AGENT); }
__device__ __forceinline__ unsigned xb_xcc_id() { return (unsigned)__builtin_amdgcn_s_getreg((3 << 11) | 20) & 0xFu; }
#define XB_SPIN(cond, bar) do { unsigned _sp = 0; while (cond) { __builtin_amdgcn_s_sleep(1); \
    if ((++_sp & 255u) == 0u) { if (xb_ld(&(bar)[XB_TMO])) break; if (_sp > XB_SPIN_CAP) { atomicAdd(&(bar)[XB_TMO], 1u); break; } } } } while (0)

struct XcdBarrier {
    unsigned* bar; unsigned x;
    volatile LAS unsigned* st;
};

__device__ __forceinline__ XcdBarrier xcd_barrier_post(unsigned* bar, volatile LAS unsigned* st) {
    XcdBarrier b; b.bar = bar; b.x = xb_xcc_id(); b.st = st;
    if (threadIdx.x == 0) (void)xb_add(&bar[XB_XCNT(b.x)], 1u);
    return b;
}
__device__ __forceinline__ void xcd_barrier_complete(unsigned* bar, unsigned x, unsigned& nloc, unsigned& nx) {
    const unsigned G = gridDim.x * gridDim.y * gridDim.z;
    unsigned sum, cnt, mine, sp = 0u;
    for (;;) {
        sum = 0u; cnt = 0u; mine = 0u;
#pragma unroll
        for (unsigned j = 0; j < 16; ++j) { const unsigned c = xb_ld(&bar[XB_XCNT(j)]); sum += c; cnt += (c > 0u) ? 1u : 0u; mine = (j == x) ? c : mine; }
        if (sum == G) break;
        __builtin_amdgcn_s_sleep(1);
        if ((++sp & 255u) == 0u) { if (xb_ld(&bar[XB_TMO])) break; if (sp > XB_SPIN_CAP) { atomicAdd(&bar[XB_TMO], 1u); break; } }
    }
    nloc = mine > 0u ? mine : 1u; nx = cnt > 0u ? cnt : 1u;
}

__device__ __forceinline__ void xcd_barrier(const XcdBarrier& b) {
    asm volatile("s_waitcnt vmcnt(0)" ::: "memory");
    __syncthreads();
    if (threadIdx.x == 0) {
        unsigned* bar = b.bar;
        __builtin_amdgcn_s_waitcnt(0);
        unsigned nloc = b.st[0], nx = b.st[1];
        if (nloc == 0u) { xcd_barrier_complete(bar, b.x, nloc, nx); b.st[0] = nloc; b.st[1] = nx; }
        const unsigned old = xb_add(&bar[XB_XSUB(b.x)], 1u);
        const unsigned gen = old / nloc;
        if (old + 1u == (gen + 1u) * nloc) {
            __builtin_amdgcn_fence(__ATOMIC_RELEASE, "agent");
            asm volatile("s_waitcnt vmcnt(0)" ::: "memory");
            const unsigned og = xb_add(&bar[XB_TOP], 1u);
            const unsigned tg = og / nx;
            if (og + 1u == (tg + 1u) * nx) xb_add(&bar[XB_TOPGEN], 1u);
            else XB_SPIN(xb_ld(&bar[XB_TOPGEN]) == tg, bar);
            __builtin_amdgcn_fence(__ATOMIC_ACQUIRE, "agent");
            xb_add(&bar[XB_XGEN(b.x)], 1u);
            asm volatile("s_waitcnt vmcnt(0)" ::: "memory");
        } else {
            XB_SPIN(xb_ld(&bar[XB_XGEN(b.x)]) == gen, bar);
            __builtin_amdgcn_fence(__ATOMIC_ACQUIRE, "agent");
            asm volatile("s_waitcnt vmcnt(0)" ::: "memory");
        }
    }
    __syncthreads();
}

constexpr int NWAVES = 8;
constexpr int DM = 1024, NZ = 3072;
constexpr int MP = 32768, MS = 512, MROWS = MP + MS, MALL = MROWS + 1024;
constexpr int ZC_CB = 0, ZC_CC = 384, ZC_CH = 768, ZC_CZ = 1152, ZC_Q = 1536, ZC_SZ = 1920, ZC_MQ = 2304, ZC_MZ = 2560, ZC_K = 2816, ZC_V = 2944;
constexpr float RMS_EPS = 1e-6f;
constexpr float LOG2E = 1.4426950408889634f;
using pg8::OFF_Y; using pg8::OFF_CP; using pg8::OFF_KP; using pg8::OFF_VP; using pg8::OFF_MKP; using pg8::OFF_MVP; using pg8::OFF_CS; using pg8::OFF_KS; using pg8::OFF_VS;
constexpr size_t MiB = 1u << 20;
constexpr size_t WS_CTL = 0, CTL_ZERO_BYTES = 1 * MiB;
constexpr size_t WS_WT = 2 * MiB;
constexpr size_t WS_WOT = 9 * MiB;
constexpr size_t WS_MK = 11 * MiB;
constexpr size_t WS_MVT = 11 * MiB + 512 * 1024;
constexpr size_t WS_VT = 12 * MiB;
constexpr size_t WS_XN = 20 * MiB;
constexpr size_t WS_Z = 88 * MiB;
constexpr size_t WS_Y = 284 * MiB;
constexpr size_t WS_END = 350 * MiB;
constexpr int CW_BAR = 4096;
constexpr int RING_BYTES = 131072, LDSCTL_OFF = 139264, MISC_OFF = LDSCTL_OFF + 320, LDS_BYTES = 147456;

typedef float f32x16 __attribute__((ext_vector_type(16)));
typedef short s16x4 __attribute__((ext_vector_type(4)));
typedef unsigned u32x2 __attribute__((ext_vector_type(2)));

__device__ __forceinline__ float wave_sum(float v) {
#pragma unroll
    for (int o = 1; o < 64; o <<= 1) v += __shfl_xor(v, o);
    return v;
}
__device__ __forceinline__ unsigned cvtpk(float lo, float hi) { unsigned r; asm("v_cvt_pk_bf16_f32 %0, %1, %2" : "=v"(r) : "v"(lo), "v"(hi)); return r; }
__device__ __forceinline__ float bflo(unsigned w) { return __uint_as_float(w << 16); }
__device__ __forceinline__ float bfhi(unsigned w) { return __uint_as_float(w & 0xffff0000u); }
__device__ __forceinline__ float silu_f(float x) { return x * __builtin_amdgcn_rcpf(1.0f + __builtin_amdgcn_exp2f(-x * LOG2E)); }
__device__ __forceinline__ int crow(int r, int hi) { return (r & 3) + 8 * (r >> 2) + 4 * hi; }

__device__ __forceinline__ int newcol(int n0) {
    if (n0 < 1920) return n0;
    if (n0 < 2048) return n0 - 1920 + ZC_K;
    if (n0 < 2176) return n0 - 2048 + ZC_V;
    if (n0 < 2560) return n0 - 2176 + ZC_SZ;
    if (n0 < 2816) return n0 - 2560 + ZC_MQ;
    return n0 - 2816 + ZC_MZ;
}
__device__ __forceinline__ void p0_transpose_item(const float* W, const float* g, float cs, int K, int N, bf16* WT, int dst_row0, LAS float* scr, int kb, int n0, int lane) {
    const int k0 = 64 * kb;
#pragma unroll 8
    for (int i = 0; i < 32; ++i) { const int kk = 2 * i + (lane >> 5); const float gv = (g ? g[k0 + kk] : 1.0f) * cs; scr[kk * 33 + (lane & 31)] = W[(size_t)(k0 + kk) * N + n0 + (lane & 31)] * gv; }
    LDS_WAIT(); asm volatile("" ::: "memory");
    const int c = lane & 7;
#pragma unroll
    for (int j = 0; j < 4; ++j) { const int n = (lane >> 3) + 8 * j; const LAS float* s = scr + (8 * c) * 33 + n;
        v4u o; o.x = pk2(s[0 * 33], s[1 * 33]); o.y = pk2(s[2 * 33], s[3 * 33]); o.z = pk2(s[4 * 33], s[5 * 33]); o.w = pk2(s[6 * 33], s[7 * 33]);
        *(GAS v4u*)(WT + (size_t)(dst_row0 + n) * K + k0 + 8 * c) = o; }
    LDS_WAIT(); asm volatile("" ::: "memory");
}
__device__ __forceinline__ void rms_row_to_bf16(const float* xrow, bf16* orow, int lane) {
    const GAS f32x4* xr = (const GAS f32x4*)xrow + lane;
    f32x4 v[4]; float s = 0.f;
#pragma unroll
    for (int j = 0; j < 4; ++j) { v[j] = xr[64 * j]; s += (v[j].x * v[j].x + v[j].y * v[j].y) + (v[j].z * v[j].z + v[j].w * v[j].w); }
    const float rstd = 1.f / sqrtf(wave_sum(s) * (1.f / DM) + RMS_EPS);
    GAS unsigned long long* o8 = (GAS unsigned long long*)orow + lane;
#pragma unroll
    for (int j = 0; j < 4; ++j) o8[64 * j] = (unsigned long long)cvtpk(v[j].x * rstd, v[j].y * rstd) | ((unsigned long long)cvtpk(v[j].z * rstd, v[j].w * rstd) << 32);
}

constexpr int KPITCH = 272, VPITCH = 520;
constexpr int KIMG_OFF = 0, VIMG_OFF = 256 * KPITCH, IMG_END = VIMG_OFF + 128 * VPITCH;
struct KvLds {
    const LAS unsigned char* kimg; const LAS unsigned char* vimg; int kt_min;
    __device__ __forceinline__ bool tile_ok(int kt) const { return kt >= kt_min; }
    __device__ __forceinline__ bf16x8 kfrag(int kt, int s, int r32, int hi) const {
        return *(const LAS bf16x8*)(kimg + (32 * kt + r32) * KPITCH + 32 * s + 16 * hi);
    }
    __device__ __forceinline__ bf16x8 vfrag(int kt, int s2, int dt, int r32, int hi) const {
        const LAS unsigned char* p = vimg + (32 * dt + r32) * VPITCH + (32 * kt + 16 * s2 + 4 * hi) * 2;
        const s16x4 a = *(const LAS s16x4*)p, b = *(const LAS s16x4*)(p + 16);
        return (bf16x8){a[0], a[1], a[2], a[3], b[0], b[1], b[2], b[3]};
    }
};
struct KvF32 {
    const float* k0; const float* k1; const float* v0; const float* v1; int pitch, n0, ntot;
    __device__ __forceinline__ bool tile_ok(int) const { return true; }
    __device__ __forceinline__ const float* row(const float* b0, const float* b1, int j) const { return j < n0 ? b0 + (long)j * pitch : (j < ntot ? b1 + (long)(j - n0) * pitch : nullptr); }
    __device__ __forceinline__ bf16x8 kfrag(int kt, int s, int r32, int hi) const {
        const float* p = row(k0, k1, 32 * kt + r32);
        f32x4 a = {0.f, 0.f, 0.f, 0.f}, b = a;
        if (p) { a = *(const f32x4*)(p + 16 * s + 8 * hi); b = *(const f32x4*)(p + 16 * s + 8 * hi + 4); }
        const unsigned w0 = cvtpk(a[0], a[1]), w1 = cvtpk(a[2], a[3]), w2 = cvtpk(b[0], b[1]), w3 = cvtpk(b[2], b[3]);
        return __builtin_bit_cast(bf16x8, (v4u){w0, w1, w2, w3});
    }
    __device__ __forceinline__ bf16x8 vfrag(int kt, int s2, int dt, int r32, int hi) const {
        float v[8];
#pragma unroll
        for (int e = 0; e < 8; ++e) { const float* p = row(v0, v1, 32 * kt + 16 * s2 + 8 * (e >> 2) + 4 * hi + (e & 3)); v[e] = p ? p[32 * dt + r32] : 0.f; }
        const unsigned w0 = cvtpk(v[0], v[1]), w1 = cvtpk(v[2], v[3]), w2 = cvtpk(v[4], v[5]), w3 = cvtpk(v[6], v[7]);
        return __builtin_bit_cast(bf16x8, (v4u){w0, w1, w2, w3});
    }
};
struct AttnState { float m, l; f32x16 o0, o1; };
__device__ __forceinline__ void attn_init(AttnState& st, float m0) {
    st.m = m0; st.l = 0.f;
    st.o0 = (f32x16){0.f, 0.f, 0.f, 0.f, 0.f, 0.f, 0.f, 0.f, 0.f, 0.f, 0.f, 0.f, 0.f, 0.f, 0.f, 0.f}; st.o1 = st.o0;
}
template <bool MASK, class KV>
__device__ __forceinline__ void attn_core(const KV& kv, const bf16x8 (&qf)[4], int qi, float slope2, int kt0, int kt1, AttnState& st, int r32, int hi) {
#pragma unroll 1
    for (int kt = kt0; kt < kt1; ++kt) {
        if (!kv.tile_ok(kt)) continue;
        f32x16 sa;
        if (MASK) { const float base = slope2 * (float)(32 * kt + 4 * hi - 128 - qi);
#pragma unroll
            for (int r = 0; r < 16; ++r) sa[r] = fmaf(slope2, (float)((r & 3) + 8 * (r >> 2)), base);
        } else {
#pragma unroll
            for (int r = 0; r < 16; ++r) sa[r] = 0.f;
        }
#pragma unroll
        for (int s = 0; s < 4; ++s) sa = __builtin_amdgcn_mfma_f32_32x32x16_bf16(kv.kfrag(kt, s, r32, hi), qf[s], sa, 0, 0, 0);
        if (MASK && (kt == 0 || kt == 4)) {
#pragma unroll
            for (int r = 0; r < 16; ++r) { const int dist = 128 + qi - (32 * kt + crow(r, hi)); sa[r] = (dist >= 0 && dist < 128) ? sa[r] : -1.0e30f; }
        }
        float tmax = sa[0];
#pragma unroll
        for (int r = 1; r < 16; ++r) tmax = fmaxf(tmax, sa[r]);
        tmax = fmaxf(tmax, __shfl_xor(tmax, 32));
        const float m_new = fmaxf(st.m, tmax), alpha = __builtin_amdgcn_exp2f(st.m - m_new);
        st.m = m_new; st.l *= alpha;
#pragma unroll
        for (int r = 0; r < 16; ++r) { st.o0[r] *= alpha; st.o1[r] *= alpha; }
        float p[16];
#pragma unroll
        for (int r = 0; r < 16; ++r) { p[r] = __builtin_amdgcn_exp2f(sa[r] - m_new); st.l += p[r]; }
#pragma unroll
        for (int s2 = 0; s2 < 2; ++s2) {
            const unsigned w0 = cvtpk(p[8 * s2 + 0], p[8 * s2 + 1]), w1 = cvtpk(p[8 * s2 + 2], p[8 * s2 + 3]), w2 = cvtpk(p[8 * s2 + 4], p[8 * s2 + 5]), w3 = cvtpk(p[8 * s2 + 6], p[8 * s2 + 7]);
            const bf16x8 pf = __builtin_bit_cast(bf16x8, (v4u){w0, w1, w2, w3});
            st.o0 = __builtin_amdgcn_mfma_f32_32x32x16_bf16(kv.vfrag(kt, s2, 0, r32, hi), pf, st.o0, 0, 0, 0);
            st.o1 = __builtin_amdgcn_mfma_f32_32x32x16_bf16(kv.vfrag(kt, s2, 1, r32, hi), pf, st.o1, 0, 0, 0);
        }
    }
}
__device__ __forceinline__ void load_q(bf16x8 (&qf)[4], const bf16* qptr, int hi) {
#pragma unroll
    for (int s = 0; s < 4; ++s) qf[s] = qptr ? *(const bf16x8*)(qptr + 16 * s + 8 * hi) : (bf16x8){0, 0, 0, 0, 0, 0, 0, 0};
}
__device__ __forceinline__ void load_gate(u32x2 (&gt)[8], const bf16* gptr, int hi) {
#pragma unroll
    for (int i = 0; i < 8; ++i) gt[i] = *(const u32x2*)(gptr + 32 * (i >> 2) + 8 * (i & 3) + 4 * hi);
}
__device__ __forceinline__ void attn_finish(const AttnState& st, bool use_sink, float sink2, const u32x2 (&gt)[8], bf16* yptr, int hi) {
    float sum = st.l + __shfl_xor(st.l, 32);
    if (use_sink) sum += __builtin_amdgcn_exp2f(sink2 - st.m);
    const float inv = 1.0f / sum;
    if (yptr) {
#pragma unroll
        for (int dt = 0; dt < 2; ++dt) {
#pragma unroll
            for (int g4 = 0; g4 < 4; ++g4) {
                const int d = 32 * dt + 8 * g4 + 4 * hi; const u32x2 gw = gt[dt * 4 + g4];
                const float q0 = dt ? st.o1[4 * g4 + 0] : st.o0[4 * g4 + 0], q1 = dt ? st.o1[4 * g4 + 1] : st.o0[4 * g4 + 1], q2 = dt ? st.o1[4 * g4 + 2] : st.o0[4 * g4 + 2], q3 = dt ? st.o1[4 * g4 + 3] : st.o0[4 * g4 + 3];
                const float y0 = q0 * inv * silu_f(bflo(gw.x)), y1 = q1 * inv * silu_f(bfhi(gw.x));
                const float y2 = q2 * inv * silu_f(bflo(gw.y)), y3 = q3 * inv * silu_f(bfhi(gw.y));
                u32x2 w; w.x = cvtpk(y0, y1); w.y = cvtpk(y2, y3);
                *(u32x2*)(yptr + d) = w;
            }
        }
    }
}

__device__ __forceinline__ float alibi_slope2(int h) { return __builtin_amdgcn_exp2f(-8.0f * (float)(h + 1) / 6.0f) * LOG2E; }

struct Args { const float* in[17]; float* out; unsigned char* ws; };

__device__ __forceinline__ void stage_kv(LAS unsigned char* L, const bf16* ksrc, long kpitch, const bf16* vsrc, long vpitch, bool skip_lo, int tid) {
    v4u kr[8], vr[8];
    const int krow = tid >> 4, kc = tid & 15, vrow = tid >> 5, vc = tid & 31;
#pragma unroll
    for (int i = 0; i < 8; ++i) { const int row = krow + 32 * i; if (!(skip_lo && row < 128)) kr[i] = *(const v4u*)(ksrc + (long)row * kpitch + kc * 8); else kr[i] = (v4u){0u, 0u, 0u, 0u}; }
#pragma unroll
    for (int i = 0; i < 8; ++i) { const int row = vrow + 16 * i; if (!(skip_lo && vc < 16)) vr[i] = *(const v4u*)(vsrc + (long)row * vpitch + vc * 8); else vr[i] = (v4u){0u, 0u, 0u, 0u}; }
#pragma unroll
    for (int i = 0; i < 8; ++i) *(LAS v4u*)(L + KIMG_OFF + (krow + 32 * i) * KPITCH + kc * 16) = kr[i];
#pragma unroll
    for (int i = 0; i < 8; ++i) { LAS unsigned char* p = L + VIMG_OFF + (vrow + 16 * i) * VPITCH + vc * 16;
        *(LAS u32x2*)p = (u32x2){vr[i].x, vr[i].y}; *(LAS u32x2*)(p + 8) = (u32x2){vr[i].z, vr[i].w}; }
}

__device__ __forceinline__ void p2_mixers(const Args& a, LAS unsigned char* L, int G, int c, int tid, int lane, int wave) {
    const bf16* Z = (const bf16*)(a.ws + WS_Z); bf16* Y = (bf16*)(a.ws + WS_Y);
    const bf16* VT = (const bf16*)(a.ws + WS_VT); const bf16* MK = (const bf16*)(a.ws + WS_MK); const bf16* MVT = (const bf16*)(a.ws + WS_MVT);
    const float* conv_w = a.in[11]; const float* sinks = a.in[12];
    const int r32 = lane & 31, hi = lane >> 5;
    for (int base = c; base < 256; base += G) {
        AttnState st; bf16x8 qf[4]; u32x2 gt[8]; bf16* yp = nullptr; float sink2 = 0.f; bool use_sink = false;
        if (wave < 4) {
            const int mj = 2 * base + (wave >> 1), half = wave & 1, b = mj >> 2, hm = mj & 3;
            KvF32 kv; kv.pitch = 256; kv.n0 = 256; kv.ntot = 256;
            kv.k0 = a.in[6] + (size_t)b * 65536 + hm * 64; kv.k1 = kv.k0; kv.v0 = a.in[7] + (size_t)b * 65536 + hm * 64; kv.v1 = kv.v0;
            const bool ok = r32 < 4; const int tq = r32 & 3;
            const size_t row = (size_t)MP + b * 4 + tq;
            load_q(qf, ok ? Z + row * NZ + ZC_MQ + hm * 64 : nullptr, hi);
            load_gate(gt, Z + row * NZ + ZC_MZ + hm * 64, hi);
            yp = ok ? Y + row * DM + 768 + hm * 64 : nullptr;
            attn_init(st, -3.0e38f);
            attn_core<false, KvF32>(kv, qf, 0, 0.f, 4 * half, 4 * half + 4, st, r32, hi);
            if (half == 1) {
                LAS float* mb = (LAS float*)L + ((wave >> 1) * 64 + lane) * 34;
                mb[0] = st.m; mb[1] = st.l;
#pragma unroll
                for (int r = 0; r < 16; ++r) { mb[2 + r] = st.o0[r]; mb[18 + r] = st.o1[r]; }
            }
        } else if (wave == 4) {
            const int b = base >> 1, kvh = base & 1;
            KvF32 kv; kv.pitch = 128; kv.n0 = 128; kv.ntot = 132;
            kv.k0 = a.in[4] + (size_t)b * 16384 + kvh * 64; kv.k1 = a.out + OFF_KS + (size_t)(b * 128 + 124) * 128 + kvh * 64;
            kv.v0 = a.in[5] + (size_t)b * 16384 + kvh * 64; kv.v1 = a.out + OFF_VS + (size_t)(b * 128 + 124) * 128 + kvh * 64;
            const bool ok = r32 < 12; const int g = r32 >> 2, tq = r32 & 3, hq = kvh * 3 + (ok ? g : 0);
            const size_t row = (size_t)MP + b * 4 + tq;
            load_q(qf, ok ? Z + row * NZ + ZC_Q + hq * 64 : nullptr, hi);
            load_gate(gt, Z + row * NZ + ZC_SZ + hq * 64, hi);
            yp = ok ? Y + row * DM + 384 + hq * 64 : nullptr;
            sink2 = sinks[hq] * LOG2E; use_sink = true;
            attn_init(st, sink2);
            attn_core<true, KvF32>(kv, qf, tq, alibi_slope2(hq), 0, 5, st, r32, hi);
        }
        __syncthreads();
        if (wave < 4 && (wave & 1) == 0) {
            const LAS float* mb = (const LAS float*)L + ((wave >> 1) * 64 + lane) * 34;
            const float m2 = mb[0], l2 = mb[1], mn = fmaxf(st.m, m2), a1 = __builtin_amdgcn_exp2f(st.m - mn), a2 = __builtin_amdgcn_exp2f(m2 - mn);
            st.m = mn; st.l = st.l * a1 + l2 * a2;
#pragma unroll
            for (int r = 0; r < 16; ++r) { st.o0[r] = st.o0[r] * a1 + mb[2 + r] * a2; st.o1[r] = st.o1[r] * a1 + mb[18 + r] * a2; }
            attn_finish(st, false, 0.f, gt, yp, hi);
        } else if (wave == 4) attn_finish(st, true, sink2, gt, yp, hi);
        __syncthreads();
    }
    for (int it = c * 512 + tid; it < 128 * 48; it += G * 512) {
        const int b = it / 48, c0 = (it % 48) * 8;
        float w0[8], w1[8], w2[8], up2[8], up1[8];
#pragma unroll
        for (int e = 0; e < 8; ++e) { w0[e] = conv_w[c0 + e]; w1[e] = conv_w[384 + c0 + e]; w2[e] = conv_w[768 + c0 + e]; up2[e] = a.in[3][(size_t)(b * 2 + 0) * 384 + c0 + e]; up1[e] = a.in[3][(size_t)(b * 2 + 1) * 384 + c0 + e]; }
#pragma unroll
        for (int t = 0; t < 4; ++t) {
            const size_t row = (size_t)MP + b * 4 + t; const bf16* zr = Z + row * NZ + c0;
            const v4u cb = *(const v4u*)(zr + ZC_CB), cc = *(const v4u*)(zr + ZC_CC), ch = *(const v4u*)(zr + ZC_CH), cz = *(const v4u*)(zr + ZC_CZ);
            float u[8], y[8];
#pragma unroll
            for (int e = 0; e < 4; ++e) { u[2 * e] = bflo(cc[e]) * bflo(ch[e]); u[2 * e + 1] = bfhi(cc[e]) * bfhi(ch[e]); }
#pragma unroll
            for (int e = 0; e < 8; ++e) { const float cv = w0[e] * up2[e] + w1[e] * up1[e] + w2[e] * u[e];
                const float cbv = (e & 1) ? bfhi(cb[e >> 1]) : bflo(cb[e >> 1]), czv = (e & 1) ? bfhi(cz[e >> 1]) : bflo(cz[e >> 1]);
                y[e] = cbv * cv * silu_f(czv); up2[e] = up1[e]; up1[e] = u[e]; }
            v4u w; w.x = cvtpk(y[0], y[1]); w.y = cvtpk(y[2], y[3]); w.z = cvtpk(y[4], y[5]); w.w = cvtpk(y[6], y[7]);
            *(v4u*)(Y + row * DM + c0) = w;
            if (t >= 2) { float* sp = a.out + OFF_CS + (size_t)(b * 2 + (t - 2)) * 384 + c0;
                *(f32x4*)sp = (f32x4){u[0], u[1], u[2], u[3]}; *(f32x4*)(sp + 4) = (f32x4){u[4], u[5], u[6], u[7]}; }
        }
    }
    for (int unit = c; unit < 256; unit += G) {
        const int b = unit >> 6, nb = unit & 63;
        const size_t row0 = (size_t)b * 8192 + nb * 128;
        if (tid < 480) {
            const int c0 = (tid % 48) * 8, tg = tid / 48;
            float w0[8], w1[8], w2[8];
#pragma unroll
            for (int e = 0; e < 8; ++e) { w0[e] = conv_w[c0 + e]; w1[e] = conv_w[384 + c0 + e]; w2[e] = conv_w[768 + c0 + e]; }
#pragma unroll 2
            for (int tt = tg; tt < 128; tt += 10) {
                const int t = nb * 128 + tt; const size_t row = row0 + tt; const bf16* zr = Z + row * NZ + c0;
                const v4u cb = *(const v4u*)(zr + ZC_CB), cc = *(const v4u*)(zr + ZC_CC), ch = *(const v4u*)(zr + ZC_CH), cz = *(const v4u*)(zr + ZC_CZ);
                v4u cc1 = {0u, 0u, 0u, 0u}, ch1 = cc1, cc2 = cc1, ch2 = cc1;
                if (t >= 1) { cc1 = *(const v4u*)(zr - NZ + ZC_CC); ch1 = *(const v4u*)(zr - NZ + ZC_CH); }
                if (t >= 2) { cc2 = *(const v4u*)(zr - 2 * NZ + ZC_CC); ch2 = *(const v4u*)(zr - 2 * NZ + ZC_CH); }
                float u[8], y[8];
#pragma unroll
                for (int e = 0; e < 4; ++e) {
                    u[2 * e] = bflo(cc[e]) * bflo(ch[e]); u[2 * e + 1] = bfhi(cc[e]) * bfhi(ch[e]);
                    const float u1a = bflo(cc1[e]) * bflo(ch1[e]), u1b = bfhi(cc1[e]) * bfhi(ch1[e]), u2a = bflo(cc2[e]) * bflo(ch2[e]), u2b = bfhi(cc2[e]) * bfhi(ch2[e]);
                    const float cva = w0[2 * e] * u2a + w1[2 * e] * u1a + w2[2 * e] * u[2 * e], cvb = w0[2 * e + 1] * u2b + w1[2 * e + 1] * u1b + w2[2 * e + 1] * u[2 * e + 1];
                    y[2 * e] = bflo(cb[e]) * cva * silu_f(bflo(cz[e])); y[2 * e + 1] = bfhi(cb[e]) * cvb * silu_f(bfhi(cz[e]));
                }
                v4u w; w.x = cvtpk(y[0], y[1]); w.y = cvtpk(y[2], y[3]); w.z = cvtpk(y[4], y[5]); w.w = cvtpk(y[6], y[7]);
                *(v4u*)(Y + row * DM + c0) = w;
                if (t >= 8190) { float* sp = a.out + OFF_CP + (size_t)(b * 2 + (t - 8190)) * 384 + c0;
                    *(f32x4*)sp = (f32x4){u[0], u[1], u[2], u[3]}; *(f32x4*)(sp + 4) = (f32x4){u[4], u[5], u[6], u[7]}; }
            }
        }
        stage_kv(L, Z + ((long)row0 - 128) * NZ + ZC_K, NZ, VT + (size_t)(b * 128) * 8192 + (nb * 128 - 128), 8192, nb == 0, tid);
        __syncthreads();
#pragma unroll 1
        for (int jj = wave; jj < 24; jj += 8) {
            const int hq = jj >> 2, qs = jj & 3, kvh = hq / 3;
            const size_t row = row0 + qs * 32 + r32;
            bf16x8 qf[4]; u32x2 gt[8];
            load_q(qf, Z + row * NZ + ZC_Q + hq * 64, hi);
            load_gate(gt, Z + row * NZ + ZC_SZ + hq * 64, hi);
            KvLds kv; kv.kimg = L + KIMG_OFF + (32 * qs) * KPITCH + kvh * 128; kv.vimg = L + VIMG_OFF + (kvh * 64) * VPITCH + (32 * qs) * 2;
            kv.kt_min = (nb == 0) ? (4 - qs) : 0;
            const float sink2 = sinks[hq] * LOG2E;
            AttnState st; attn_init(st, sink2);
            attn_core<true, KvLds>(kv, qf, r32, alibi_slope2(hq), 0, 5, st, r32, hi);
            attn_finish(st, true, sink2, gt, Y + row * DM + 384 + hq * 64, hi);
        }
#pragma unroll 1
        for (int hp = 0; hp < 2; ++hp) {
            const int hm = 2 * hp + (wave >> 2), qs = wave & 3;
            const size_t row = row0 + qs * 32 + r32;
            bf16x8 qf[4]; u32x2 gt[8];
            load_q(qf, Z + row * NZ + ZC_MQ + hm * 64, hi);
            load_gate(gt, Z + row * NZ + ZC_MZ + hm * 64, hi);
            __syncthreads();
            stage_kv(L, MK + (size_t)b * 65536 + hp * 128, 256, MVT + (size_t)(b * 256 + hp * 128) * 256, 256, false, tid);
            __syncthreads();
            KvLds kv; kv.kimg = L + KIMG_OFF + (wave >> 2) * 128; kv.vimg = L + VIMG_OFF + ((wave >> 2) * 64) * VPITCH; kv.kt_min = 0;
            AttnState st; attn_init(st, -3.0e38f);
            attn_core<false, KvLds>(kv, qf, 0, 0.f, 0, 8, st, r32, hi);
            attn_finish(st, false, 0.f, gt, Y + row * DM + 768 + hm * 64, hi);
        }
        __syncthreads();
    }
}

__global__ void __launch_bounds__(NWAVES * 64, 2) mega_fwd(Args a) {
    extern __shared__ __attribute__((aligned(16))) unsigned char lds[];
    LAS unsigned char* L = (LAS unsigned char*)lds;
    volatile LAS unsigned* MISC = (volatile LAS unsigned*)(L + MISC_OFF);
    const int tid = threadIdx.x, lane = tid & 63, wave = __builtin_amdgcn_readfirstlane(tid >> 6);
    const int G = gridDim.x, c = blockIdx.x;
    for (int u = tid; u < (LDS_BYTES - LDSCTL_OFF) / 4; u += NWAVES * 64) ((LAS unsigned*)(L + LDSCTL_OFF))[u] = 0u;
    __syncthreads();
    gu32* ctl = (gu32*)(a.ws + WS_CTL);
    XcdBarrier bar = xcd_barrier_post((unsigned*)(ctl + CW_BAR), MISC + 8);

    bf16* WT = (bf16*)(a.ws + WS_WT); bf16* WOT = (bf16*)(a.ws + WS_WOT); bf16* XN = (bf16*)(a.ws + WS_XN);
    bf16* Zb = (bf16*)(a.ws + WS_Z); bf16* Yb = (bf16*)(a.ws + WS_Y); bf16* YRAW = (bf16*)(a.ws + WS_XN);

    {
        LAS float* scr = (LAS float*)(L + wave * 16384);
        const int gw = c * NWAVES + wave, NGW = G * NWAVES;
        constexpr int I_IN = 16 * 96, I_OUT = 16 * 32, I_MK = 16 * 8;
        for (int it = gw; it < I_IN + I_OUT + 2 * I_MK; it += NGW) {
            int r = it;
            if (r < I_IN) { const int kb = r / 96, n0 = 32 * (r % 96); p0_transpose_item(a.in[10], a.in[8], ((n0 >= 1536 && n0 < 1920) || (n0 >= 2560 && n0 < 2816)) ? 0.125f * LOG2E : 1.0f, 1024, 3072, WT, newcol(n0), scr, kb, n0, lane); continue; } r -= I_IN;
            if (r < I_OUT) { const int kb = r / 32, n0 = 32 * (r % 32); p0_transpose_item(a.in[16], nullptr, 1.0f, 1024, 1024, WOT, n0, scr, kb, n0, lane); continue; } r -= I_OUT;
            if (r < I_MK) { const int kb = r / 8, n0 = 32 * (r % 8); p0_transpose_item(a.in[14], a.in[13], 1.0f, 1024, 256, WT, 3072 + n0, scr, kb, n0, lane); continue; } r -= I_MK;
            { const int kb = r / 8, n0 = 32 * (r % 8); p0_transpose_item(a.in[15], a.in[13], 1.0f, 1024, 256, WT, 3328 + n0, scr, kb, n0, lane); }
        }
        for (int m = gw; m < MALL; m += NGW) {
            const float* src = m < MP ? a.in[0] + (size_t)m * DM : (m < MROWS ? a.in[1] + (size_t)(m - MP) * DM : a.in[2] + (size_t)(m - MROWS) * DM);
            rms_row_to_bf16(src, XN + (size_t)m * DM, lane);
        }
        for (int i = c * 512 + tid; i < 2 * 128 * 3968; i += G * 512) {
            const int which = i / (128 * 3968), r = i % (128 * 3968), b = r / 3968, e = r % 3968;
            const f32x4 v = *((const f32x4*)(a.in[4 + which] + (size_t)b * 16384 + 512) + e);
            *((f32x4*)(a.out + (which ? OFF_VS : OFF_KS) + (size_t)b * 16384) + e) = v;
        }
    }
    xcd_barrier(bar);
    {
        pg8::Gemm g{XN, WT, MALL, 3584, 1024}; pg8::OrderP1 S; S.init(G, c);
        pg8::EpiZ E{Zb, (bf16*)(a.ws + WS_VT), (bf16*)(a.ws + WS_MK), (bf16*)(a.ws + WS_MVT), a.out};
        pg8::gemm_phase<pg8::EpiZ, pg8::OrderP1, true, true>(L, g, S, E);
    }
    xcd_barrier(bar);
#ifndef NO_P2
    p2_mixers(a, L, G, c, tid, lane, wave);
#endif
    xcd_barrier(bar);
    {
        pg8::Gemm g{Yb, WOT, MROWS, 1024, 1024}; pg8::StaticOrder S; S.init(MROWS, 1024, G, c);
        pg8::EpiPlain E{YRAW, 1024};
        pg8::gemm_phase<pg8::EpiPlain, pg8::StaticOrder, true, true>(L, g, S, E);
    }
    xcd_barrier(bar);
    {
        const int gw = c * NWAVES + wave, NGW = G * NWAVES;
        const float* gp = a.in[9];
        f32x4 gv[4];
#pragma unroll
        for (int j = 0; j < 4; ++j) gv[j] = *((const f32x4*)gp + lane + 64 * j);
        for (int m = gw; m < MROWS; m += NGW) {
            const float* xs = m < MP ? a.in[0] + (size_t)m * DM : a.in[1] + (size_t)(m - MP) * DM;
            const u32x2* yr = (const u32x2*)(YRAW + (size_t)m * DM) + lane;
            float yv[4][4]; float s = 0.f;
#pragma unroll
            for (int j = 0; j < 4; ++j) { const u32x2 w = yr[64 * j]; yv[j][0] = bflo(w.x); yv[j][1] = bfhi(w.x); yv[j][2] = bflo(w.y); yv[j][3] = bfhi(w.y);
                s += (yv[j][0] * yv[j][0] + yv[j][1] * yv[j][1]) + (yv[j][2] * yv[j][2] + yv[j][3] * yv[j][3]); }
            const float rstd = 1.f / sqrtf(wave_sum(s) * (1.f / DM) + RMS_EPS);
            float* orow = a.out + OFF_Y + (size_t)m * DM;
#pragma unroll
            for (int j = 0; j < 4; ++j) { const f32x4 xv = *((const f32x4*)xs + lane + 64 * j);
                f32x4 o; o.x = xv.x + yv[j][0] * rstd * gv[j].x; o.y = xv.y + yv[j][1] * rstd * gv[j].y; o.z = xv.z + yv[j][2] * rstd * gv[j].z; o.w = xv.w + yv[j][3] * rstd * gv[j].w;
                *((f32x4*)orow + lane + 64 * j) = o; }
        }
    }
}

extern "C" void kernel_launch(void* const* d_in, const int* in_sizes, int n_in, void* d_out, int out_size, void* d_ws, size_t ws_size, hipStream_t stream) {
    static int grid = 0;
    if (grid == 0) {
        if (n_in != 17 || ws_size < WS_END) { fprintf(stderr, "kernel_launch: unexpected inputs (n_in %d, ws %zu)\n", n_in, ws_size); grid = -1; return; }
        int dev = 0, cus = 0, per_cu = 0;
        hipGetDevice(&dev); hipDeviceGetAttribute(&cus, hipDeviceAttributeMultiprocessorCount, dev);
        hipFuncSetAttribute((const void*)mega_fwd, hipFuncAttributeMaxDynamicSharedMemorySize, LDS_BYTES);
        if (hipOccupancyMaxActiveBlocksPerMultiprocessor(&per_cu, (const void*)mega_fwd, NWAVES * 64, LDS_BYTES) != hipSuccess || per_cu < 1) { fprintf(stderr, "kernel_launch: occupancy query says %d\n", per_cu); (void)hipGetLastError(); per_cu = 1; }
        grid = cus;
    }
    if (grid < 0) return;
    hipMemsetAsync((char*)d_ws + WS_CTL, 0, CTL_ZERO_BYTES, stream);
    Args a{};
    for (int i = 0; i < 17; ++i) a.in[i] = (const float*)d_in[i];
    a.out = (float*)d_out; a.ws = (unsigned char*)d_ws;
    hipLaunchKernelGGL(mega_fwd, dim3(grid), dim3(NWAVES * 64), LDS_BYTES, stream, a);
}
```
